# Optimizing an MI355X kernel written in HIP

```python
import jax, jax.numpy as jnp
from jax import lax
import numpy as np

D_MODEL = 1024
BATCH = 4
SEQ = 4096
DEPTH = 2
DEC_BATCH = 16
DEC_SEQ = 16
PAST_LEN = 4096

CHUNK = 64
Q_BLOCK = 128
EPS = 1e-6
A_CHUNK = 128
A_GROUPS = 4
A_GROUP_DIM = 128
A_HALF = A_GROUPS * A_GROUP_DIM
B_HEADS = 8
B_KV_HEADS = 2
B_HEAD_DIM = 64
B_TOPK_MAX = 256
IDX_HEADS = 8
IDX_DIM = 32
C_HEADS = 8
C_HEAD_DIM = 64
N_BRANCH = 3
D_FF = ((8 * D_MODEL // 3 + 255) // 256) * 256
PLE_DIM = 256
IN_COLS = (2 * A_HALF + (B_HEADS + 2 * B_KV_HEADS) * B_HEAD_DIM + IDX_HEADS * IDX_DIM + IDX_DIM
           + IDX_HEADS + 3 * C_HEADS * C_HEAD_DIM + N_BRANCH * D_MODEL)

kernel_name = 'hybrid_gmlp_dsa_stickbreak_stream_step'


def rms_norm(x, g):
    xf = x.astype(jnp.float32)
    y = xf * lax.rsqrt(jnp.mean(xf * xf, axis=-1, keepdims=True) + EPS)
    return (y * g.astype(jnp.float32)).astype(x.dtype)


def split_columns(z):
    sizes = (A_HALF, A_HALF, B_HEADS * B_HEAD_DIM, B_KV_HEADS * B_HEAD_DIM, B_KV_HEADS * B_HEAD_DIM,
             IDX_HEADS * IDX_DIM, IDX_DIM, IDX_HEADS, C_HEADS * C_HEAD_DIM, C_HEADS * C_HEAD_DIM,
             C_HEADS * C_HEAD_DIM, N_BRANCH * D_MODEL)
    offs, acc = [], 0
    for s in sizes[:-1]:
        acc += s
        offs.append(acc)
    return jnp.split(z, offs, axis=-1)


def to_blocks(a):
    b, s = a.shape[:2]
    return a.reshape(b, s // Q_BLOCK, Q_BLOCK, *a.shape[2:]).swapaxes(0, 1)


def from_blocks(o):
    nb, b, qb = o.shape[:3]
    return o.swapaxes(0, 1).reshape(b, nb * qb, *o.shape[3:])


def gmlp_spatial(u, v, ws, bias):
    b, t, _ = v.shape
    nc = -(-t // A_CHUNK)
    vp = jnp.pad(v, ((0, 0), (0, nc * A_CHUNK - t), (0, 0)))
    vp = vp.reshape(b, nc, A_CHUNK, A_GROUPS, A_GROUP_DIM)
    i = jnp.arange(A_CHUNK)
    mask = (i[None, :] // CHUNK) <= (i[:, None] // CHUNK)
    wm = jnp.where(mask[None], ws, 0)
    mixed = jnp.einsum('gij,bcjgd->bcigd', wm, vp) + bias.T[None, None, :, :, None]
    mixed = mixed.reshape(b, nc * A_CHUNK, A_HALF)[:, :t]
    return u * mixed


def dsa_attend(q, qi, wi, q_pos, k, v, ki, k_pos, topk):
    f32 = jnp.float32
    b, nq = q.shape[:2]
    dots = jnp.einsum('bqhe,ble->bqhl', qi.astype(f32), ki.astype(f32)) * (IDX_DIM ** -0.5)
    score = jnp.einsum('bqhl,bqh->bql', jax.nn.relu(dots), wi.astype(f32))
    admissible = (k_pos[None, :] // CHUNK) <= (q_pos[:, None] // CHUNK)
    score = jnp.where(admissible[None], score, -jnp.inf)
    _, idx = lax.top_k(score, topk)
    valid = (k_pos[idx] // CHUNK) <= (q_pos // CHUNK)[None, :, None]
    gather = jax.vmap(lambda a, ix: a[ix])
    k_sel = gather(k, idx).astype(f32)
    v_sel = gather(v, idx).astype(f32)
    qg = q.reshape(b, nq, B_KV_HEADS, B_HEADS // B_KV_HEADS, B_HEAD_DIM).astype(f32)
    logits = jnp.einsum('bqhgd,bqnhd->bqhgn', qg, k_sel) * (B_HEAD_DIM ** -0.5)
    logits = jnp.where(valid[:, :, None, None, :], logits, -jnp.inf)
    probs = jax.nn.softmax(logits, axis=-1)
    o = jnp.einsum('bqhgn,bqnhd->bqhgd', probs, v_sel)
    return o.reshape(b, nq, B_HEADS * B_HEAD_DIM).astype(q.dtype)


def dsa_prompt(q, qi, wi, k, v, ki):
    s = q.shape[1]
    topk = min(B_TOPK_MAX, s // 4)
    pos = jnp.arange(s)

    def blk(args):
        qb, qib, wib, pb = args
        return dsa_attend(qb, qib, wib, pb, k, v, ki, pos, topk)

    out = lax.map(blk, (to_blocks(q), to_blocks(qi), to_blocks(wi), pos.reshape(s // Q_BLOCK, Q_BLOCK)))
    return from_blocks(out)


def stick_breaking(q, q_pos, k, v, k_pos):
    f32 = jnp.float32
    b, nq = q.shape[:2]
    z = jnp.einsum('bqhd,blhd->bhql', q.astype(f32), k.astype(f32)) * (C_HEAD_DIM ** -0.5)
    mask = k_pos[None, :] < q_pos[:, None]
    log_stay = jnp.where(mask, jax.nn.log_sigmoid(-z), 0.0)
    after = lax.cumsum(log_stay, axis=3, reverse=True) - log_stay
    w = jnp.where(mask, jnp.exp(jax.nn.log_sigmoid(z) + after), 0.0)
    o = jnp.einsum('bhql,blhd->bqhd', w, v.astype(f32))
    return o.reshape(b, nq, C_HEADS * C_HEAD_DIM).astype(q.dtype)


def stick_prompt(q, k, v):
    s = q.shape[1]
    pos = jnp.arange(s)

    def blk(args):
        qb, pb = args
        return stick_breaking(qb, pb, k, v, pos)

    out = lax.map(blk, (to_blocks(q), pos.reshape(s // Q_BLOCK, Q_BLOCK)))
    return from_blocks(out)


def mix_projections(x, prm):
    bsz, t, _ = x.shape
    h = rms_norm(x, prm['norm_mix'])
    au, av, bq, bk, bv, iq, ik, iw, cq, ck, cv, gl = split_columns(h @ prm['w_in'])
    au = jax.nn.gelu(au)
    av = rms_norm(jax.nn.gelu(av), prm['a_vnorm'])
    bq = rms_norm(bq.reshape(bsz, t, B_HEADS, B_HEAD_DIM), prm['b_qnorm'])
    bk = rms_norm(bk.reshape(bsz, t, B_KV_HEADS, B_HEAD_DIM), prm['b_knorm'])
    bv = bv.reshape(bsz, t, B_KV_HEADS, B_HEAD_DIM)
    iq = iq.reshape(bsz, t, IDX_HEADS, IDX_DIM)
    iw = iw * (IDX_HEADS ** -0.5)
    cq = cq.reshape(bsz, t, C_HEADS, C_HEAD_DIM)
    ck = ck.reshape(bsz, t, C_HEADS, C_HEAD_DIM)
    cv = cv.reshape(bsz, t, C_HEADS, C_HEAD_DIM)
    gates = jax.nn.sigmoid(gl + prm['gate_bias']).reshape(bsz, t, N_BRANCH, D_MODEL)
    return au, av, bq, bk, bv, iq, ik, iw, cq, ck, cv, gates


def run_layer(x, p, prm, past):
    au, av, bq, bk, bv, iq, ik, iw, cq, ck, cv, gates = mix_projections(x, prm)
    oa = gmlp_spatial(au, av, prm['a_ws'], prm['a_bias'])
    if past is None:
        ob = dsa_prompt(bq, iq, iw, bk, bv, ik)
        oc = stick_prompt(cq, ck, cv)
    else:
        pbk, pbv, pik, pck, pcv = past
        t = x.shape[1]
        n_past = pbk.shape[1]
        n_keys = n_past + t
        k_pos = jnp.arange(n_keys)
        q_pos = n_past + jnp.arange(t)
        ob = dsa_attend(bq, iq, iw, q_pos,
                        jnp.concatenate([pbk, bk], axis=1), jnp.concatenate([pbv, bv], axis=1),
                        jnp.concatenate([pik, ik], axis=1), k_pos, min(B_TOPK_MAX, n_keys // 4))
        oc = stick_breaking(cq, q_pos, jnp.concatenate([pck, ck], axis=1),
                            jnp.concatenate([pcv, cv], axis=1), k_pos)
    merged = (gates[:, :, 0] * (oa @ prm['w_br_a']) + gates[:, :, 1] * (ob @ prm['w_br_b'])
              + gates[:, :, 2] * (oc @ prm['w_br_c']))
    x = x + merged @ prm['w_out']
    hf = rms_norm(x, prm['norm_ffn'])
    g, up = jnp.split(hf @ prm['w_ffn_in'], 2, axis=-1)
    x = x + (jax.nn.silu(g) * up) @ prm['w_ffn_out']
    ple_gate = jax.nn.sigmoid(rms_norm(x, prm['norm_ple']) @ prm['w_ple_gate'])
    x = x + ple_gate * (p @ prm['w_ple_proj'])
    return x, (bk, bv, ik, ck, cv, av)


def stack_layers(states, i):
    return jnp.stack([s[i] for s in states])


def setup_inputs(seed: int = 0) -> dict:
    key = jax.random.key(seed)
    ks = jax.random.split(key, 32)

    def nrm(k, shape, scale=1.0):
        return jax.random.normal(k, shape, jnp.float32) * scale

    def gain(k, shape):
        return 1.0 + nrm(k, shape, 0.01)

    return {
        'x_prompt': nrm(ks[0], (BATCH, SEQ, D_MODEL)),
        'x_sample': nrm(ks[1], (DEC_BATCH, DEC_SEQ, D_MODEL)),
        'cache_b_k': nrm(ks[2], (DEPTH, DEC_BATCH, PAST_LEN, B_KV_HEADS, B_HEAD_DIM)),
        'cache_b_v': nrm(ks[3], (DEPTH, DEC_BATCH, PAST_LEN, B_KV_HEADS, B_HEAD_DIM)),
        'cache_b_kidx': nrm(ks[4], (DEPTH, DEC_BATCH, PAST_LEN, IDX_DIM)),
        'cache_c_k': nrm(ks[5], (DEPTH, DEC_BATCH, PAST_LEN, C_HEADS, C_HEAD_DIM)),
        'cache_c_v': nrm(ks[6], (DEPTH, DEC_BATCH, PAST_LEN, C_HEADS, C_HEAD_DIM)),
        'p_prompt': nrm(ks[7], (DEPTH, BATCH, SEQ, PLE_DIM)),
        'p_sample': nrm(ks[8], (DEPTH, DEC_BATCH, DEC_SEQ, PLE_DIM)),
        'norm_mix': gain(ks[9], (DEPTH, D_MODEL)),
        'w_in': nrm(ks[10], (DEPTH, D_MODEL, IN_COLS), D_MODEL ** -0.5),
        'gate_bias': nrm(ks[11], (DEPTH, N_BRANCH * D_MODEL), 0.01),
        'a_vnorm': gain(ks[12], (DEPTH, A_HALF)),
        'a_ws': nrm(ks[13], (DEPTH, A_GROUPS, A_CHUNK, A_CHUNK), A_CHUNK ** -0.5),
        'a_bias': 1.0 + nrm(ks[14], (DEPTH, A_GROUPS, A_CHUNK), 0.1),
        'b_qnorm': gain(ks[15], (DEPTH, B_HEAD_DIM)),
        'b_knorm': gain(ks[16], (DEPTH, B_HEAD_DIM)),
        'w_br_a': nrm(ks[17], (DEPTH, A_HALF, D_MODEL), A_HALF ** -0.5),
        'w_br_b': nrm(ks[18], (DEPTH, B_HEADS * B_HEAD_DIM, D_MODEL), (B_HEADS * B_HEAD_DIM) ** -0.5),
        'w_br_c': nrm(ks[19], (DEPTH, C_HEADS * C_HEAD_DIM, D_MODEL), (C_HEADS * C_HEAD_DIM) ** -0.5),
        'w_out': nrm(ks[20], (DEPTH, D_MODEL, D_MODEL), D_MODEL ** -0.5),
        'norm_ffn': gain(ks[21], (DEPTH, D_MODEL)),
        'w_ffn_in': nrm(ks[22], (DEPTH, D_MODEL, 2 * D_FF), D_MODEL ** -0.5),
        'w_ffn_out': nrm(ks[23], (DEPTH, D_FF, D_MODEL), D_FF ** -0.5),
        'norm_ple': gain(ks[24], (DEPTH, D_MODEL)),
        'w_ple_gate': nrm(ks[25], (DEPTH, D_MODEL, D_MODEL), D_MODEL ** -0.5),
        'w_ple_proj': nrm(ks[26], (DEPTH, PLE_DIM, D_MODEL), PLE_DIM ** -0.5),
    }


def reference(x_prompt, x_sample, cache_b_k, cache_b_v, cache_b_kidx, cache_c_k, cache_c_v,
              p_prompt, p_sample, norm_mix, w_in, gate_bias, a_vnorm, a_ws, a_bias, b_qnorm, b_knorm,
              w_br_a, w_br_b, w_br_c, w_out, norm_ffn, w_ffn_in, w_ffn_out, norm_ple, w_ple_gate,
              w_ple_proj):
    yp, ys = x_prompt, x_sample
    new_p, new_s = [], []
    for l in range(DEPTH):
        prm = {
            'norm_mix': norm_mix[l], 'w_in': w_in[l], 'gate_bias': gate_bias[l],
            'a_vnorm': a_vnorm[l], 'a_ws': a_ws[l], 'a_bias': a_bias[l],
            'b_qnorm': b_qnorm[l], 'b_knorm': b_knorm[l],
            'w_br_a': w_br_a[l], 'w_br_b': w_br_b[l], 'w_br_c': w_br_c[l], 'w_out': w_out[l],
            'norm_ffn': norm_ffn[l], 'w_ffn_in': w_ffn_in[l], 'w_ffn_out': w_ffn_out[l],
            'norm_ple': norm_ple[l], 'w_ple_gate': w_ple_gate[l], 'w_ple_proj': w_ple_proj[l],
        }
        yp, st_p = run_layer(yp, p_prompt[l], prm, None)
        ys, st_s = run_layer(ys, p_sample[l], prm,
                             (cache_b_k[l], cache_b_v[l], cache_b_kidx[l], cache_c_k[l], cache_c_v[l]))
        new_p.append(st_p)
        new_s.append(st_s)
    return (yp, ys,
            stack_layers(new_p, 0), stack_layers(new_p, 1), stack_layers(new_p, 2),
            stack_layers(new_p, 3), stack_layers(new_p, 4),
            stack_layers(new_s, 0), stack_layers(new_s, 1), stack_layers(new_s, 2),
            stack_layers(new_s, 3), stack_layers(new_s, 4), stack_layers(new_s, 5))
```

```cpp
#include <hip/hip_runtime.h>
#include <hip/hip_cooperative_groups.h>
#include <stdint.h>
#include <cstdio>
namespace cg = cooperative_groups;

typedef unsigned short bf16_t;
typedef short bf16x8 __attribute__((ext_vector_type(8)));
typedef float f32x4 __attribute__((ext_vector_type(4)));
typedef unsigned u32x4 __attribute__((ext_vector_type(4)));
typedef unsigned u32x2 __attribute__((ext_vector_type(2)));
#define DEVI __device__ __forceinline__

constexpr int DM = 1024, NPR = 16384, NSM = 256, MT = NPR + NSM, SEQ = 4096, PAST = 4096;
constexpr int NIN = 6784, INSRC = 6696, DFF = 2816, NFFI = 5632;
constexpr float EPS = 1e-6f;
constexpr int O_YP = 0;
constexpr int O_YS = O_YP + NPR * DM;
constexpr int O_BKP = O_YS + NSM * DM;
constexpr int O_BVP = O_BKP + 2 * NPR * 128;
constexpr int O_IKP = O_BVP + 2 * NPR * 128;
constexpr int O_CKP = O_IKP + 2 * NPR * 32;
constexpr int O_CVP = O_CKP + 2 * NPR * 512;
constexpr int O_BKS = O_CVP + 2 * NPR * 512;
constexpr int O_BVS = O_BKS + 2 * NSM * 128;
constexpr int O_IKS = O_BVS + 2 * NSM * 128;
constexpr int O_CKS = O_IKS + 2 * NSM * 32;
constexpr int O_CVS = O_CKS + 2 * NSM * 512;
constexpr int O_AVS = O_CVS + 2 * NSM * 512;

constexpr int SMEM_HALF = 35328;
#define XCD_BAR_WORDS 3456

struct Params {
    const float *x_prompt, *x_sample, *cache_b_k, *cache_b_v, *cache_b_kidx, *cache_c_k, *cache_c_v, *p_prompt, *p_sample;
    const float *norm_mix, *w_in, *gate_bias, *a_vnorm, *a_ws, *a_bias, *b_qnorm, *b_knorm, *w_br_a, *w_br_b, *w_br_c, *w_out;
    const float *norm_ffn, *w_ffn_in, *w_ffn_out, *norm_ple, *w_ple_gate, *w_ple_proj;
    float* out;
    bf16_t *Win, *Wa, *Wb, *Wc, *Wout, *Wffi, *Wffo, *Wpg, *Wpp, *WS;
    float* X;
    bf16_t *H, *AU, *AVp, *BQ, *BK, *BV, *IQ, *IK;
    float* IW;
    bf16_t *CQ, *CK, *CV, *G, *OA, *OB, *OC, *MG, *ACT, *P;
    unsigned* bar;
};

typedef const __attribute__((address_space(4))) Params* CP;
DEVI CP launder(CP q) { asm volatile("" : "+s"(q)); return q; }

DEVI int tid_() { int t = __builtin_amdgcn_workitem_id_x(); asm volatile("" : "+v"(t)); return t; }
typedef float f32x2_t __attribute__((ext_vector_type(2)));
typedef __bf16 bf16x2_t __attribute__((ext_vector_type(2)));
DEVI unsigned pk_bf16(float lo, float hi) { const f32x2_t v = {lo, hi}; return __builtin_bit_cast(unsigned, __builtin_convertvector(v, bf16x2_t)); }
DEVI float bf_lo(unsigned u) { return __uint_as_float(u << 16); }
DEVI float bf_hi(unsigned u) { return __uint_as_float(u & 0xffff0000u); }
DEVI void st_bf4(bf16_t* dst, f32x4 v) { u32x2 w; w.x = pk_bf16(v[0], v[1]); w.y = pk_bf16(v[2], v[3]); *(u32x2*)dst = w; }
DEVI float sigmoidf_(float x) { return __builtin_amdgcn_rcpf(1.0f + __expf(-x)); }
DEVI float gelu_tanh(float x) { float u = 0.7978845608028654f * (x + 0.044715f * x * x * x); return x * sigmoidf_(2.0f * u); }
DEVI f32x4 mfma16(bf16x8 a, bf16x8 b, f32x4 c) { return __builtin_amdgcn_mfma_f32_16x16x32_bf16(a, b, c, 0, 0, 0); }
DEVI bf16x8 pack8(f32x4 a, f32x4 b) {
    u32x4 w; w.x = pk_bf16(a[0], a[1]); w.y = pk_bf16(a[2], a[3]); w.z = pk_bf16(b[0], b[1]); w.w = pk_bf16(b[2], b[3]);
    return __builtin_bit_cast(bf16x8, w);
}
DEVI bf16x8 zero8() { u32x4 w = {0u, 0u, 0u, 0u}; return __builtin_bit_cast(bf16x8, w); }
DEVI void wave_sync() {
    __builtin_amdgcn_fence(__ATOMIC_RELEASE, "wavefront");
    __builtin_amdgcn_wave_barrier();
    __builtin_amdgcn_fence(__ATOMIC_ACQUIRE, "wavefront");
}
template <int CTRL> DEVI float dppf(float v) { return __builtin_bit_cast(float, __builtin_amdgcn_update_dpp(0, __builtin_bit_cast(int, v), CTRL, 0xf, 0xf, true)); }
template <int CTRL> DEVI int dppi(int v) { return __builtin_amdgcn_update_dpp(0, v, CTRL, 0xf, 0xf, true); }
DEVI float wave_sum(float v) {
    v += dppf<0xB1>(v); v += dppf<0x4E>(v); v += dppf<0x141>(v); v += dppf<0x140>(v);
    v += __shfl_xor(v, 16); v += __shfl_xor(v, 32);
    return v;
}
DEVI float wave_max(float v) {
    v = fmaxf(v, dppf<0xB1>(v)); v = fmaxf(v, dppf<0x4E>(v)); v = fmaxf(v, dppf<0x141>(v)); v = fmaxf(v, dppf<0x140>(v));
    v = fmaxf(v, __shfl_xor(v, 16)); v = fmaxf(v, __shfl_xor(v, 32));
    return v;
}
DEVI int wave_sum_i(int v) {
    v += dppi<0xB1>(v); v += dppi<0x4E>(v); v += dppi<0x141>(v); v += dppi<0x140>(v);
    v += __shfl_xor(v, 16); v += __shfl_xor(v, 32);
    return v;
}
DEVI int wave_min_i(int v) {
#pragma unroll
    for (int o = 1; o < 64; o <<= 1) { const int t = __shfl_xor(v, o); v = t < v ? t : v; }
    return v;
}
DEVI float* state_out(float* out, int offP, int offS, int l, int row, int W) {
    return (row < NPR) ? out + offP + (size_t)(l * NPR + row) * W : out + offS + (size_t)(l * NSM + (row - NPR)) * W;
}

typedef __attribute__((address_space(3))) unsigned char* LdsP;
template <int NT>
DEVI void gemm_acc(f32x4 (&acc)[4][NT], const bf16_t* __restrict__ A, int lda, const bf16_t* __restrict__ Bt, int ldb, int K, unsigned char* smem0, unsigned char* smem1) {
    const int tid = tid_(), lane = tid & 63, wid = __builtin_amdgcn_readfirstlane(tid >> 6), wr = wid >> 1, wc = wid & 1, fr = lane & 15, fq = lane >> 4;
    LdsP lds0 = (LdsP)smem0;
    LdsP lds1 = (LdsP)smem1;
    constexpr int ABYTES = 128 * 128;
    const int csw = (lane & 7) ^ (((wid & 1) << 2) | (lane >> 4));
    const int rl = wid * 8 + (lane >> 3);
    const bf16_t* Ag = A + (size_t)rl * lda + csw * 8;
    const bf16_t* Bg = Bt + (size_t)rl * ldb + csw * 8;
    const int sw = fr >> 1;
    const int aoff = (wr * 64 + fr) * 128;
    const int boff = ABYTES + (wc * (NT * 16) + fr) * 128;
    const int nk = K >> 6;
    __syncthreads();
#define GEMM_ISSUE(kt_, L_) do { \
        _Pragma("unroll") for (int i_ = 0; i_ < 4; ++i_) \
            __builtin_amdgcn_global_load_lds((const unsigned*)(Ag + (size_t)(32 * i_) * lda + (kt_) * 64), (__attribute__((address_space(3))) unsigned*)((L_) + wid * 1024 + i_ * 4096), 16, 0, 0); \
        _Pragma("unroll") for (int i_ = 0; i_ < NT; ++i_) \
            __builtin_amdgcn_global_load_lds((const unsigned*)(Bg + (size_t)(32 * i_) * ldb + (kt_) * 64), (__attribute__((address_space(3))) unsigned*)((L_) + ABYTES + wid * 1024 + i_ * 4096), 16, 0, 0); \
    } while (0)
#define GEMM_COMPUTE(L_) do { \
        _Pragma("unroll") for (int ks = 0; ks < 2; ++ks) { \
            const int co = ((ks * 4 + fq) ^ sw) << 4; \
            bf16x8 af[4], bfr[NT]; \
            _Pragma("unroll") for (int m = 0; m < 4; ++m) af[m] = *(const __attribute__((address_space(3))) bf16x8*)((L_) + aoff + m * 2048 + co); \
            _Pragma("unroll") for (int n = 0; n < NT; ++n) bfr[n] = *(const __attribute__((address_space(3))) bf16x8*)((L_) + boff + n * 2048 + co); \
            __builtin_amdgcn_s_setprio(1); \
            _Pragma("unroll") for (int m = 0; m < 4; ++m) \
                _Pragma("unroll") for (int n = 0; n < NT; ++n) acc[m][n] = mfma16(bfr[n], af[m], acc[m][n]); \
            __builtin_amdgcn_s_setprio(0); \
        } } while (0)
    GEMM_ISSUE(0, lds0);
    for (int kt = 0; kt < nk; kt += 2) {
        asm volatile("s_waitcnt vmcnt(0)" ::: "memory");
        __syncthreads();
        GEMM_ISSUE(kt + 1, lds1);
        GEMM_COMPUTE(lds0);
        asm volatile("s_waitcnt vmcnt(0)" ::: "memory");
        __syncthreads();
        if (kt + 2 < nk) GEMM_ISSUE(kt + 2, lds0);
        GEMM_COMPUTE(lds1);
    }
#undef GEMM_ISSUE
#undef GEMM_COMPUTE
}
template <int NT>
DEVI void zero_acc(f32x4 (&acc)[4][NT]) {
#pragma unroll
    for (int m = 0; m < 4; ++m)
#pragma unroll
        for (int n = 0; n < NT; ++n) acc[m][n] = (f32x4){0.f, 0.f, 0.f, 0.f};
}

struct TileMap {
    int x, j, J, nct, rows, full, remr, total;
    DEVI void init(int nrt, int nct_) {
        const int G = gridDim.x;
        nct = nct_;
        if ((G & 7) == 0) { x = blockIdx.x & 7; j = blockIdx.x >> 3; J = G >> 3; rows = (nrt - x + 7) >> 3; }
        else { x = -1; j = blockIdx.x; J = G; rows = nrt; }
        full = rows >> 3; remr = rows & 7; total = rows * nct;
    }
    DEVI void get(int v, int& rt, int& ct) const {
        int g = v / (8 * nct), ri;
        if (g < full) { const int rem = v - g * 8 * nct; ct = rem >> 3; ri = rem & 7; }
        else { g = full; const int rem = v - full * 8 * nct; ct = rem / remr; ri = rem - ct * remr; }
        const int lr = g * 8 + ri;
        rt = (x >= 0) ? x + 8 * lr : lr;
    }
};

DEVI int map_col(int mode, int n) {
    if (mode == 0) return n;
    if (mode == 1) { if (n < 2088) return n; if (n < 2176) return -1; return n - 88; }
    const int T = n >> 7, wc = (n >> 6) & 1, nn = (n >> 4) & 3, i = n & 15;
    return (nn >> 1) * DFF + T * 64 + wc * 32 + (nn & 1) * 16 + i;
}
DEVI void conv_tile(const float* __restrict__ W, int Nsrc, int K, bf16_t* __restrict__ Bt, int mode, int tn, int tk, float* tile) {
    const int tid = tid_();
    {
        const int kk = tid >> 4, n4 = (tid & 15) * 4;
        const int src = map_col(mode, tn * 64 + n4);
        f32x4 v[8];
#pragma unroll
        for (int ps = 0; ps < 8; ++ps) {
            v[ps] = (f32x4){0.f, 0.f, 0.f, 0.f};
            if (src >= 0) v[ps] = __builtin_nontemporal_load((const f32x4*)(W + (size_t)(tk * 128 + ps * 16 + kk) * Nsrc + src));
        }
#pragma unroll
        for (int ps = 0; ps < 8; ++ps) {
            const int k = ps * 16 + kk;
            tile[k * 65 + n4 + 0] = v[ps][0]; tile[k * 65 + n4 + 1] = v[ps][1]; tile[k * 65 + n4 + 2] = v[ps][2]; tile[k * 65 + n4 + 3] = v[ps][3];
        }
    }
    __syncthreads();
    {
        const int n = tid & 63, kc = (tid >> 6) * 32;
        bf16_t* dst = Bt + (size_t)(tn * 64 + n) * K + tk * 128 + kc;
#pragma unroll
        for (int q = 0; q < 4; ++q) {
            u32x4 w;
            w.x = pk_bf16(tile[(kc + q * 8 + 0) * 65 + n], tile[(kc + q * 8 + 1) * 65 + n]);
            w.y = pk_bf16(tile[(kc + q * 8 + 2) * 65 + n], tile[(kc + q * 8 + 3) * 65 + n]);
            w.z = pk_bf16(tile[(kc + q * 8 + 4) * 65 + n], tile[(kc + q * 8 + 5) * 65 + n]);
            w.w = pk_bf16(tile[(kc + q * 8 + 6) * 65 + n], tile[(kc + q * 8 + 7) * 65 + n]);
            *(u32x4*)(dst + q * 8) = w;
        }
    }
    __syncthreads();
}

DEVI void norm_phase(const float* __restrict__ srcP, const float* __restrict__ srcS, const float* __restrict__ gain, bf16_t* __restrict__ H, float* __restrict__ Xcopy) {
    const int lane = tid_() & 63;
    const int gw = blockIdx.x * 4 + (tid_() >> 6), nw = gridDim.x * 4;
    f32x4 g4[4];
#pragma unroll
    for (int i = 0; i < 4; ++i) g4[i] = *(const f32x4*)(gain + i * 256 + lane * 4);
    for (int r = gw; r < MT; r += nw) {
        const float* src = (r < NPR) ? srcP + (size_t)r * DM : srcS + (size_t)(r - NPR) * DM;
        f32x4 v[4];
        float ss = 0.f;
#pragma unroll
        for (int i = 0; i < 4; ++i) { v[i] = *(const f32x4*)(src + i * 256 + lane * 4); ss += v[i][0] * v[i][0] + v[i][1] * v[i][1] + v[i][2] * v[i][2] + v[i][3] * v[i][3]; }
        ss = wave_sum(ss);
        const float rstd = rsqrtf(ss * (1.0f / DM) + EPS);
#pragma unroll
        for (int i = 0; i < 4; ++i) {
            st_bf4(H + (size_t)r * DM + i * 256 + lane * 4, v[i] * rstd * g4[i]);
            if (Xcopy) *(f32x4*)(Xcopy + (size_t)r * DM + i * 256 + lane * 4) = v[i];
        }
    }
}

DEVI void phase0(CP p, unsigned char* smem) {
    float* tile = (float*)smem;
    {
        constexpr int T0 = 848, T1 = T0 + 704, T2 = T1 + 352, T3 = T2 + 128, T4 = T3 + 128, T5 = T4 + 64, T6 = T5 + 64, T7 = T6 + 64, T8 = T7 + 32;
        for (int u = blockIdx.x; u < 2 * T8; u += gridDim.x) {
            const int l = u / T8, r = u - l * T8;
            if (r < T0)      { const int t = r;      conv_tile(p->w_in + (size_t)l * DM * INSRC, INSRC, DM, p->Win + (size_t)l * NIN * DM, 1, t % 106, t / 106, tile); }
            else if (r < T1) { const int t = r - T0; conv_tile(p->w_ffn_in + (size_t)l * DM * NFFI, NFFI, DM, p->Wffi + (size_t)l * NFFI * DM, 2, t % 88, t / 88, tile); }
            else if (r < T2) { const int t = r - T1; conv_tile(p->w_ffn_out + (size_t)l * DFF * DM, DM, DFF, p->Wffo + (size_t)l * DM * DFF, 0, t % 16, t / 16, tile); }
            else if (r < T3) { const int t = r - T2; conv_tile(p->w_out + (size_t)l * DM * DM, DM, DM, p->Wout + (size_t)l * DM * DM, 0, t % 16, t / 16, tile); }
            else if (r < T4) { const int t = r - T3; conv_tile(p->w_ple_gate + (size_t)l * DM * DM, DM, DM, p->Wpg + (size_t)l * DM * DM, 0, t % 16, t / 16, tile); }
            else if (r < T5) { const int t = r - T4; conv_tile(p->w_br_a + (size_t)l * 512 * DM, DM, 512, p->Wa + (size_t)l * DM * 512, 0, t % 16, t / 16, tile); }
            else if (r < T6) { const int t = r - T5; conv_tile(p->w_br_b + (size_t)l * 512 * DM, DM, 512, p->Wb + (size_t)l * DM * 512, 0, t % 16, t / 16, tile); }
            else if (r < T7) { const int t = r - T6; conv_tile(p->w_br_c + (size_t)l * 512 * DM, DM, 512, p->Wc + (size_t)l * DM * 512, 0, t % 16, t / 16, tile); }
            else             { const int t = r - T7; conv_tile(p->w_ple_proj + (size_t)l * 256 * DM, DM, 256, p->Wpp + (size_t)l * DM * 256, 0, t % 16, t / 16, tile); }
        }
    }
    const int gt = blockIdx.x * 256 + tid_(), nt = gridDim.x * 256;
    for (int e = gt; e < 2 * 4 * 128 * 128; e += nt) {
        const int j = e & 127, i = (e >> 7) & 127;
        const float v = ((j >> 6) <= (i >> 6)) ? p->a_ws[e] : 0.f;
        p->WS[e] = (bf16_t)(pk_bf16(v, 0.f) & 0xffffu);
    }
    for (int e = gt; e < 2 * MT * 64; e += nt) {
        const int c4 = (e & 63) * 4, r = (e >> 6) % MT, l = (e >> 6) / MT;
        const float* src = (r < NPR) ? p->p_prompt + ((size_t)(l * NPR + r)) * 256 + c4 : p->p_sample + ((size_t)(l * NSM + r - NPR)) * 256 + c4;
        st_bf4(p->P + ((size_t)(l * MT + r)) * 256 + c4, __builtin_nontemporal_load((const f32x4*)src));
    }
    norm_phase(p->x_prompt, p->x_sample, p->norm_mix, p->H, p->X);
}

DEVI void phase_gemm_in(CP p, int l, unsigned char* smem, unsigned char* smem1) {
    const int tid = tid_(), lane = tid & 63, wid = tid >> 6, wr = wid >> 1, wc = wid & 1, fr = lane & 15, fq = lane >> 4;
    constexpr int NCT = NIN / 128;
    TileMap tm; tm.init(NPR / 128, NCT);
    const int nmain = (tm.total - tm.j + tm.J - 1) / tm.J;
    int extra = -1;
    if (tm.x >= 0) { const int j0 = tm.total % tm.J; if (tm.j >= j0) { const int k = (tm.j - j0) * 8 + tm.x; if (k < 2 * NCT) extra = k; } }
    else tm.init(MT / 128, NCT);
    const int nmain2 = (tm.total - tm.j + tm.J - 1) / tm.J;
    const int niter = (tm.x >= 0 ? nmain : nmain2) + (extra >= 0 ? 1 : 0);
    for (int it = 0; it < niter; ++it) {
        int ct, rt;
        if (extra < 0 || it + 1 < niter) tm.get(tm.j + it * tm.J, rt, ct);
        else { rt = NPR / 128 + extra / NCT; ct = extra % NCT; }
        f32x4 acc[4][4];
        zero_acc<4>(acc);
        gemm_acc<4>(acc, p->H + (size_t)rt * 128 * DM, DM, p->Win + ((size_t)l * NIN + ct * 128) * DM, DM, DM, smem, smem1);
        const int rbase = rt * 128 + wr * 64 + fr;
        const int cw = wc * 64 + fq * 4;
        if (ct < 8) {
            bf16_t* dst = (ct < 4) ? p->AU : p->AVp;
            const int cb = (ct & 3) * 128 + cw;
#pragma unroll
            for (int m = 0; m < 4; ++m)
#pragma unroll
                for (int n = 0; n < 4; ++n) {
                    f32x4 v = acc[m][n];
                    v[0] = gelu_tanh(v[0]); v[1] = gelu_tanh(v[1]); v[2] = gelu_tanh(v[2]); v[3] = gelu_tanh(v[3]);
                    st_bf4(dst + (size_t)(rbase + m * 16) * 512 + cb + n * 16, v);
                }
        } else if (ct < 13) {
            const float* gn = (ct < 12) ? p->b_qnorm + l * 64 : p->b_knorm + l * 64;
            f32x4 g4[4];
#pragma unroll
            for (int n = 0; n < 4; ++n) g4[n] = *(const f32x4*)(gn + n * 16 + fq * 4);
#pragma unroll
            for (int m = 0; m < 4; ++m) {
                float ss = 0.f;
#pragma unroll
                for (int n = 0; n < 4; ++n) { const f32x4 v = acc[m][n]; ss += v[0] * v[0] + v[1] * v[1] + v[2] * v[2] + v[3] * v[3]; }
                ss += __shfl_xor(ss, 16); ss += __shfl_xor(ss, 32);
                const float rstd = rsqrtf(ss * (1.0f / 64.0f) + EPS);
                const int row = rbase + m * 16;
#pragma unroll
                for (int n = 0; n < 4; ++n) {
                    const f32x4 v = acc[m][n] * rstd * g4[n];
                    if (ct < 12) st_bf4(p->BQ + (size_t)row * 512 + (ct - 8) * 128 + cw + n * 16, v);
                    else {
                        st_bf4(p->BK + (size_t)row * 128 + cw + n * 16, v);
                        __builtin_nontemporal_store(v, (f32x4*)(state_out(p->out, O_BKP, O_BKS, l, row, 128) + cw + n * 16));
                    }
                }
            }
        } else if (ct == 13) {
#pragma unroll
            for (int m = 0; m < 4; ++m)
#pragma unroll
                for (int n = 0; n < 4; ++n) {
                    const int row = rbase + m * 16;
                    st_bf4(p->BV + (size_t)row * 128 + cw + n * 16, acc[m][n]);
                    __builtin_nontemporal_store(acc[m][n], (f32x4*)(state_out(p->out, O_BVP, O_BVS, l, row, 128) + cw + n * 16));
                }
        } else if (ct < 16) {
#pragma unroll
            for (int m = 0; m < 4; ++m)
#pragma unroll
                for (int n = 0; n < 4; ++n) st_bf4(p->IQ + (size_t)(rbase + m * 16) * 256 + (ct - 14) * 128 + cw + n * 16, acc[m][n]);
        } else if (ct == 16) {
#pragma unroll
            for (int m = 0; m < 4; ++m)
#pragma unroll
                for (int n = 0; n < 4; ++n) {
                    const int row = rbase + m * 16, c = cw + n * 16;
                    if (c < 32) {
                        st_bf4(p->IK + (size_t)row * 32 + c, acc[m][n]);
                        __builtin_nontemporal_store(acc[m][n], (f32x4*)(state_out(p->out, O_IKP, O_IKS, l, row, 32) + c));
                    } else if (c < 40) {
                        *(f32x4*)(p->IW + (size_t)row * 8 + (c - 32)) = acc[m][n] * 0.35355339059327373f;
                    }
                }
        } else if (ct < 29) {
            const int seg = (ct - 17) >> 2, cb = ((ct - 17) & 3) * 128 + cw;
            bf16_t* dst = (seg == 0) ? p->CQ : (seg == 1) ? p->CK : p->CV;
#pragma unroll
            for (int m = 0; m < 4; ++m)
#pragma unroll
                for (int n = 0; n < 4; ++n) {
                    const int row = rbase + m * 16;
                    st_bf4(dst + (size_t)row * 512 + cb + n * 16, acc[m][n]);
                    if (seg == 1) __builtin_nontemporal_store(acc[m][n], (f32x4*)(state_out(p->out, O_CKP, O_CKS, l, row, 512) + cb + n * 16));
                    if (seg == 2) __builtin_nontemporal_store(acc[m][n], (f32x4*)(state_out(p->out, O_CVP, O_CVS, l, row, 512) + cb + n * 16));
                }
        } else {
            const int cb = (ct - 29) * 128 + cw;
#pragma unroll
            for (int n = 0; n < 4; ++n) {
                const f32x4 gb = *(const f32x4*)(p->gate_bias + l * 3072 + cb + n * 16);
#pragma unroll
                for (int m = 0; m < 4; ++m) {
                    f32x4 v = acc[m][n] + gb;
                    v[0] = sigmoidf_(v[0]); v[1] = sigmoidf_(v[1]); v[2] = sigmoidf_(v[2]); v[3] = sigmoidf_(v[3]);
                    st_bf4(p->G + (size_t)(rbase + m * 16) * 3072 + cb + n * 16, v);
                }
            }
        }
    }
}

DEVI void amix_unit(CP p, int l, int ch, int g, unsigned char* smem) {
    bf16_t* Vt = (bf16_t*)smem;
    float* rs = (float*)(smem + 128 * 136 * 2);
    const int tid = tid_(), lane = tid & 63, w = tid >> 6, fr = lane & 15, fq = lane >> 4;
    int row0, nvalid;
    if (ch < 128) { row0 = ch * 128; nvalid = 128; } else { row0 = NPR + (ch - 128) * 16; nvalid = 16; }
    {
        const int r = tid >> 1, hf = tid & 1;
        float ss = 0.f;
        if (r < nvalid) {
            const u32x4* src = (const u32x4*)(p->AVp + (size_t)(row0 + r) * 512 + hf * 256);
            for (int i = 0; i < 32; ++i) {
                const u32x4 v = src[i];
#pragma unroll
                for (int c = 0; c < 4; ++c) { const float a = bf_lo(v[c]), b = bf_hi(v[c]); ss += a * a + b * b; }
            }
        }
        ss += __shfl_xor(ss, 1);
        if (hf == 0) rs[r] = (r < nvalid) ? rsqrtf(ss * (1.0f / 512.0f) + EPS) : 0.f;
    }
    __syncthreads();
    {
        const int j = tid >> 1, dh = (tid & 1) * 64;
        const float rj = rs[j];
        for (int c8 = 0; c8 < 8; ++c8) {
            const int d0 = dh + c8 * 8;
            float v[8];
            if (j < nvalid) {
                const u32x4 raw = *(const u32x4*)(p->AVp + (size_t)(row0 + j) * 512 + g * 128 + d0);
                const f32x4 g0 = *(const f32x4*)(p->a_vnorm + l * 512 + g * 128 + d0), g1 = *(const f32x4*)(p->a_vnorm + l * 512 + g * 128 + d0 + 4);
                v[0] = bf_lo(raw.x) * rj * g0[0]; v[1] = bf_hi(raw.x) * rj * g0[1]; v[2] = bf_lo(raw.y) * rj * g0[2]; v[3] = bf_hi(raw.y) * rj * g0[3];
                v[4] = bf_lo(raw.z) * rj * g1[0]; v[5] = bf_hi(raw.z) * rj * g1[1]; v[6] = bf_lo(raw.w) * rj * g1[2]; v[7] = bf_hi(raw.w) * rj * g1[3];
                if (ch >= 128) {
                    float* o = p->out + O_AVS + (size_t)(l * NSM + (ch - 128) * 16 + j) * 512 + g * 128 + d0;
                    *(f32x4*)o = (f32x4){v[0], v[1], v[2], v[3]};
                    *(f32x4*)(o + 4) = (f32x4){v[4], v[5], v[6], v[7]};
                }
            } else {
#pragma unroll
                for (int e = 0; e < 8; ++e) v[e] = 0.f;
            }
#pragma unroll
            for (int e = 0; e < 8; e += 2) {
                const unsigned pk = pk_bf16(v[e], v[e + 1]);
                Vt[(d0 + e) * 136 + j] = (bf16_t)(pk & 0xffffu);
                Vt[(d0 + e + 1) * 136 + j] = (bf16_t)(pk >> 16);
            }
        }
    }
    __syncthreads();
    f32x4 acc[2][8];
#pragma unroll
    for (int mi = 0; mi < 2; ++mi)
#pragma unroll
        for (int dn = 0; dn < 8; ++dn) acc[mi][dn] = (f32x4){0.f, 0.f, 0.f, 0.f};
    const bf16_t* Wg = p->WS + (size_t)(l * 4 + g) * 128 * 128;
#pragma unroll
    for (int kk = 0; kk < 4; ++kk) {
        bf16x8 wf[2];
#pragma unroll
        for (int mi = 0; mi < 2; ++mi) wf[mi] = *(const bf16x8*)(Wg + (w * 32 + mi * 16 + fr) * 128 + kk * 32 + fq * 8);
#pragma unroll
        for (int dn = 0; dn < 8; ++dn) {
            const bf16x8 vf = *(const bf16x8*)(Vt + (dn * 16 + fr) * 136 + kk * 32 + fq * 8);
#pragma unroll
            for (int mi = 0; mi < 2; ++mi) acc[mi][dn] = mfma16(vf, wf[mi], acc[mi][dn]);
        }
    }
#pragma unroll
    for (int mi = 0; mi < 2; ++mi) {
        const int i = w * 32 + mi * 16 + fr;
        if (i < nvalid) {
            const int row = row0 + i;
            const float bias = p->a_bias[(l * 4 + g) * 128 + i];
#pragma unroll
            for (int dn = 0; dn < 8; ++dn) {
                const int d = dn * 16 + fq * 4;
                const u32x2 uu = *(const u32x2*)(p->AU + (size_t)row * 512 + g * 128 + d);
                f32x4 o;
                o[0] = bf_lo(uu.x) * (acc[mi][dn][0] + bias); o[1] = bf_hi(uu.x) * (acc[mi][dn][1] + bias);
                o[2] = bf_lo(uu.y) * (acc[mi][dn][2] + bias); o[3] = bf_hi(uu.y) * (acc[mi][dn][3] + bias);
                st_bf4(p->OA + (size_t)row * 512 + g * 128 + d, o);
            }
        }
    }
    __syncthreads();
}

template <bool SAMPLE> DEVI bf16x8 load_ik(CP p, int l, int b, int kpos, int off) {
    if (!SAMPLE) return *(const bf16x8*)(p->IK + (size_t)(b * SEQ + kpos) * 32 + off);
    const float* src;
    if (kpos < PAST) src = p->cache_b_kidx + ((size_t)(l * 16 + b) * PAST + kpos) * 32 + off;
    else if (kpos < PAST + 16) src = p->out + O_IKS + (size_t)(l * NSM + b * 16 + kpos - PAST) * 32 + off;
    else return zero8();
    return pack8(*(const f32x4*)src, *(const f32x4*)(src + 4));
}
template <bool SAMPLE> DEVI const float* kv_f32_ptr(CP p, const float* cache, int offS, int l, int b, int kidx, int kh, int off) {
    if (kidx < PAST) return cache + (((size_t)(l * 16 + b) * PAST + kidx) * 2 + kh) * 64 + off;
    return p->out + offS + ((size_t)(l * NSM + b * 16 + kidx - PAST) * 2 + kh) * 64 + off;
}

template <int NS> DEVI int select_topk(const unsigned* ukl, int* idxl, int lane, int nkeys) {
    unsigned k[NS];
#pragma unroll
    for (int i = 0; i < NS; ++i) k[i] = ukl[i * 64 + lane];
    unsigned T = 0u;
    int tie_cut = 0x7fffffff;
    bool take_eq = false;
    if (nkeys > 256) {
        for (int bit = 31; bit >= 0; --bit) {
            const unsigned cand = T | (1u << bit);
            int cnt = 0;
#pragma unroll
            for (int i = 0; i < NS; ++i) cnt += __popcll(__ballot(k[i] >= cand));
            if (cnt >= 256) T = cand;
            if (cnt == 256) break;
        }
        int cgt = 0, ceq = 0;
#pragma unroll
        for (int i = 0; i < NS; ++i) { cgt += __popcll(__ballot(k[i] > T)); ceq += __popcll(__ballot(k[i] == T)); }
        const int need = 256 - cgt;
        take_eq = need > 0;
        if (need > 0 && need < ceq) {
            int cur = -1;
            for (int it = 0; it < need; ++it) {
                int mn = 0x7fffffff;
#pragma unroll
                for (int i = 0; i < NS; ++i) { const int id = i * 64 + lane; if (k[i] == T && id > cur && id < mn) mn = id; }
                cur = wave_min_i(mn);
            }
            tie_cut = cur;
        }
    }
    int cl = 0;
#pragma unroll
    for (int i = 0; i < NS; ++i) {
        const bool sel = (k[i] > T) || (take_eq && k[i] == T && (i * 64 + lane) <= tie_cut);
        cl += sel ? 1 : 0;
    }
    int pre = cl;
#pragma unroll
    for (int o = 1; o < 64; o <<= 1) { const int t = __shfl_up(pre, o); if (lane >= o) pre += t; }
    const int base = __builtin_amdgcn_readfirstlane(__shfl(pre, 63));
    int pos = pre - cl;
#pragma unroll
    for (int i = 0; i < NS; ++i) {
        const bool sel = (k[i] > T) || (take_eq && k[i] == T && (i * 64 + lane) <= tie_cut);
        if (sel) { if (pos < 256) idxl[pos] = i * 64 + lane; ++pos; }
    }
    return base;
}

template <bool SAMPLE> DEVI void dsa_query(CP p, int l, int qrow, unsigned* ukl, int* idxl) {
    float* wl = (float*)ukl;
    qrow = __builtin_amdgcn_readfirstlane(qrow);
    const int lane = tid_() & 63, fr = lane & 15, fq = lane >> 4;
    int b, nmain, nsl, nkeys;
    if (!SAMPLE) { b = qrow >> 12; const int t = qrow & 4095; nmain = (t >> 6) + 1; nsl = nmain; nkeys = nmain * 64; }
    else { b = (qrow - NPR) >> 4; nmain = 64; nsl = 65; nkeys = PAST + 16; }
    const bf16x8 qa = *(const bf16x8*)(p->IQ + (size_t)qrow * 256 + (fr & 7) * 32 + fq * 8);
    const f32x4 w4 = *(const f32x4*)(p->IW + (size_t)qrow * 8 + (fq & 1) * 4) * 0.17677669529663687f;
    constexpr int SPI = SAMPLE ? 1 : 2;
    constexpr int GPI = SPI * 4;
    const int niter = (nmain + SPI - 1) / SPI;
    const bf16_t* kpb = p->IK + (size_t)(b * SEQ + fr) * 32 + fq * 8;
    const float* kpf = p->cache_b_kidx + ((size_t)(l * 16 + b) * PAST + fr) * 32 + fq * 8;
    bf16x8 cur[GPI], nxt[GPI];
#pragma unroll
    for (int g = 0; g < GPI; ++g) {
        if (!SAMPLE) cur[g] = *(const bf16x8*)(kpb + g * 512);
        else cur[g] = pack8(*(const f32x4*)(kpf + g * 512), *(const f32x4*)(kpf + g * 512 + 4));
    }
    for (int it = 0; it < niter; ++it) {
        kpb += GPI * 512; kpf += GPI * 512;
        if (it + 1 < niter) {
#pragma unroll
            for (int g = 0; g < GPI; ++g) {
                if (!SAMPLE) nxt[g] = *(const bf16x8*)(kpb + g * 512);
                else nxt[g] = pack8(*(const f32x4*)(kpf + g * 512), *(const f32x4*)(kpf + g * 512 + 4));
            }
        }
        float sg[GPI], tg[GPI];
#pragma unroll
        for (int g = 0; g < GPI; ++g) {
            const f32x4 d = mfma16(qa, cur[g], (f32x4){0.f, 0.f, 0.f, 0.f});
            float s_ = __builtin_amdgcn_fmed3f(d[0], 0.f, 3.0e38f) * w4[0];
            s_ = fmaf(__builtin_amdgcn_fmed3f(d[1], 0.f, 3.0e38f), w4[1], s_);
            s_ = fmaf(__builtin_amdgcn_fmed3f(d[2], 0.f, 3.0e38f), w4[2], s_);
            s_ = fmaf(__builtin_amdgcn_fmed3f(d[3], 0.f, 3.0e38f), w4[3], s_);
            sg[g] = s_;
        }
#pragma unroll
        for (int g = 0; g < GPI; ++g) tg[g] = __shfl_xor(sg[g], 16);
#pragma unroll
        for (int sl = 0; sl < SPI; ++sl) {
            float sc = 0.f;
#pragma unroll
            for (int g = 0; g < 4; ++g) { const float v = sg[sl * 4 + g] + tg[sl * 4 + g]; if (fq == g) sc = v; }
            sc += 0.0f;
            const unsigned u = __float_as_uint(sc);
            ukl[(it * SPI + sl) * 64 + lane] = (u & 0x80000000u) ? ~u : (u | 0x80000000u);
        }
#pragma unroll
        for (int g = 0; g < GPI; ++g) cur[g] = nxt[g];
    }
    if (SAMPLE) {
        const float* src = p->out + O_IKS + (size_t)(l * NSM + b * 16 + fr) * 32 + fq * 8;
        const bf16x8 kb = pack8(*(const f32x4*)src, *(const f32x4*)(src + 4));
        const f32x4 d = mfma16(qa, kb, (f32x4){0.f, 0.f, 0.f, 0.f});
        float s = __builtin_amdgcn_fmed3f(d[0], 0.f, 3.0e38f) * w4[0];
        s = fmaf(__builtin_amdgcn_fmed3f(d[1], 0.f, 3.0e38f), w4[1], s);
        s = fmaf(__builtin_amdgcn_fmed3f(d[2], 0.f, 3.0e38f), w4[2], s);
        s = fmaf(__builtin_amdgcn_fmed3f(d[3], 0.f, 3.0e38f), w4[3], s);
        s += __shfl_xor(s, 16);
        s += 0.0f;
        const unsigned u = __float_as_uint(s);
        const unsigned key = (u & 0x80000000u) ? ~u : (u | 0x80000000u);
        ukl[64 * 64 + lane] = (fq == 0) ? key : 0u;
    }
    int base;
    if (SAMPLE) base = select_topk<65>(ukl, idxl, lane, nkeys);
    else {
        const int ns16 = (nsl + 15) & ~15;
        for (int i = nsl; i < ns16; ++i) ukl[i * 64 + lane] = 0u;
        if (ns16 == 16) base = select_topk<16>(ukl, idxl, lane, nkeys);
        else if (ns16 == 32) base = select_topk<32>(ukl, idxl, lane, nkeys);
        else if (ns16 == 48) base = select_topk<48>(ukl, idxl, lane, nkeys);
        else base = select_topk<64>(ukl, idxl, lane, nkeys);
    }
    const int nsel = base < 256 ? base : 256;
    const int ngr = (nsel + 15) >> 4;
    wave_sync();
    {
        constexpr int GL = SAMPLE ? 2 : 4;
        bf16x8 qf[2][2];
#pragma unroll
        for (int kh = 0; kh < 2; ++kh)
#pragma unroll
            for (int ks = 0; ks < 2; ++ks) {
                qf[kh][ks] = zero8();
                if (fr < 4) qf[kh][ks] = *(const bf16x8*)(p->BQ + (size_t)qrow * 512 + (kh * 4 + fr) * 64 + ks * 32 + fq * 8);
            }
        for (int gi0 = 0; gi0 < ngr; gi0 += GL) {
            bf16x8 kb[GL][2][2];
#pragma unroll
            for (int j = 0; j < GL; ++j) {
                const int n = (gi0 + j) * 16 + fr;
                const int kidx = (n < nsel) ? idxl[n] : 0;
#pragma unroll
                for (int kh = 0; kh < 2; ++kh)
#pragma unroll
                    for (int ks = 0; ks < 2; ++ks) {
                        if (!SAMPLE) kb[j][kh][ks] = *(const bf16x8*)(p->BK + (size_t)(b * SEQ + kidx) * 128 + kh * 64 + ks * 32 + fq * 8);
                        else { const float* s_ = kv_f32_ptr<SAMPLE>(p, p->cache_b_k, O_BKS, l, b, kidx, kh, ks * 32 + fq * 8); kb[j][kh][ks] = pack8(*(const f32x4*)s_, *(const f32x4*)(s_ + 4)); }
                    }
            }
#pragma unroll
            for (int j = 0; j < GL; ++j) {
                const int n = (gi0 + j) * 16 + fr;
#pragma unroll
                for (int kh = 0; kh < 2; ++kh) {
                    f32x4 d = (f32x4){0.f, 0.f, 0.f, 0.f};
                    d = mfma16(qf[kh][0], kb[j][kh][0], d);
                    d = mfma16(qf[kh][1], kb[j][kh][1], d);
                    if (fq == 0 && gi0 + j < ngr) {
                        f32x4 v = d * 0.125f;
                        if (n >= nsel) v = (f32x4){-INFINITY, -INFINITY, -INFINITY, -INFINITY};
                        *(f32x4*)(wl + (kh * 256 + n) * 4) = v;
                    }
                }
            }
        }
    }
    wave_sync();
#pragma unroll
    for (int kh = 0; kh < 2; ++kh) {
        f32x4 x[4];
        f32x4 mx = (f32x4){-INFINITY, -INFINITY, -INFINITY, -INFINITY};
#pragma unroll
        for (int k = 0; k < 4; ++k) {
            const int n = lane + 64 * k;
            x[k] = (n < ngr * 16) ? *(const f32x4*)(wl + (kh * 256 + n) * 4) : (f32x4){-INFINITY, -INFINITY, -INFINITY, -INFINITY};
#pragma unroll
            for (int c = 0; c < 4; ++c) mx[c] = fmaxf(mx[c], x[k][c]);
        }
#pragma unroll
        for (int c = 0; c < 4; ++c) mx[c] = wave_max(mx[c]);
        f32x4 sm = (f32x4){0.f, 0.f, 0.f, 0.f};
#pragma unroll
        for (int k = 0; k < 4; ++k)
#pragma unroll
            for (int c = 0; c < 4; ++c) { x[k][c] = __expf(x[k][c] - mx[c]); sm[c] += x[k][c]; }
#pragma unroll
        for (int c = 0; c < 4; ++c) sm[c] = 1.0f / wave_sum(sm[c]);
#pragma unroll
        for (int k = 0; k < 4; ++k) {
            const int n = lane + 64 * k;
            if (n < ngr * 16) *(f32x4*)(wl + (kh * 256 + n) * 4) = x[k] * sm;
        }
    }
    wave_sync();
    const int kq = lane >> 3, dc = lane & 7;
#pragma unroll
    for (int kh = 0; kh < 2; ++kh) {
        float o[4][8];
#pragma unroll
        for (int hh = 0; hh < 4; ++hh)
#pragma unroll
            for (int e = 0; e < 8; ++e) o[hh][e] = 0.f;
        constexpr int KB = SAMPLE ? 4 : 8;
        constexpr int RW = SAMPLE ? 2 : 1;
        f32x4 ppC[KB], ppN[KB];
        u32x4 rwC[KB][RW], rwN[KB][RW];
#define PV_LOAD(n0_, PP_, RW_) do { \
        _Pragma("unroll") for (int j = 0; j < KB; ++j) { \
            const int n = (n0_) + 8 * j; \
            const bool ok = n < nsel; \
            const int kidx = ok ? idxl[n] : 0; \
            PP_[j] = ok ? *(const f32x4*)(wl + (kh * 256 + n) * 4) : (f32x4){0.f, 0.f, 0.f, 0.f}; \
            if (!SAMPLE) RW_[j][0] = *(const u32x4*)(p->BV + (size_t)(b * SEQ + kidx) * 128 + kh * 64 + dc * 8); \
            else { const float* s_ = kv_f32_ptr<SAMPLE>(p, p->cache_b_v, O_BVS, l, b, kidx, kh, dc * 8); \
                   RW_[j][0] = *(const u32x4*)s_; RW_[j][RW - 1] = *(const u32x4*)(s_ + 4); } \
        } } while (0)
        PV_LOAD(kq, ppC, rwC);
        for (int n0 = kq; n0 < nsel; n0 += 8 * KB) {
            if (n0 + 8 * KB < nsel) PV_LOAD(n0 + 8 * KB, ppN, rwN);
#pragma unroll
            for (int j = 0; j < KB; ++j) {
                float v[8];
                if (!SAMPLE) {
                    v[0] = bf_lo(rwC[j][0].x); v[1] = bf_hi(rwC[j][0].x); v[2] = bf_lo(rwC[j][0].y); v[3] = bf_hi(rwC[j][0].y);
                    v[4] = bf_lo(rwC[j][0].z); v[5] = bf_hi(rwC[j][0].z); v[6] = bf_lo(rwC[j][0].w); v[7] = bf_hi(rwC[j][0].w);
                } else {
                    v[0] = __uint_as_float(rwC[j][0].x); v[1] = __uint_as_float(rwC[j][0].y); v[2] = __uint_as_float(rwC[j][0].z); v[3] = __uint_as_float(rwC[j][0].w);
                    v[4] = __uint_as_float(rwC[j][RW - 1].x); v[5] = __uint_as_float(rwC[j][RW - 1].y); v[6] = __uint_as_float(rwC[j][RW - 1].z); v[7] = __uint_as_float(rwC[j][RW - 1].w);
                }
#pragma unroll
                for (int hh = 0; hh < 4; ++hh)
#pragma unroll
                    for (int e = 0; e < 8; ++e) o[hh][e] = fmaf(ppC[j][hh], v[e], o[hh][e]);
            }
#pragma unroll
            for (int j = 0; j < KB; ++j) { ppC[j] = ppN[j];
#pragma unroll
                for (int q = 0; q < RW; ++q) rwC[j][q] = rwN[j][q]; }
        }
#undef PV_LOAD
#pragma unroll
        for (int hh = 0; hh < 4; ++hh)
#pragma unroll
            for (int e = 0; e < 8; ++e) {
                float t = o[hh][e];
                t += dppf<0x128>(t); t += __shfl_xor(t, 16); t += __shfl_xor(t, 32);
                o[hh][e] = t;
            }
        if (kq == 0) {
#pragma unroll
            for (int hh = 0; hh < 4; ++hh) {
                u32x4 w;
                w.x = pk_bf16(o[hh][0], o[hh][1]); w.y = pk_bf16(o[hh][2], o[hh][3]); w.z = pk_bf16(o[hh][4], o[hh][5]); w.w = pk_bf16(o[hh][6], o[hh][7]);
                *(u32x4*)(p->OB + (size_t)qrow * 512 + (kh * 4 + hh) * 64 + dc * 8) = w;
            }
        }
    }
    wave_sync();
}

template <bool SAMPLE> DEVI void stick_unit(CP p, int l, int b, int h, int qt, unsigned char* smem) {
    bf16_t* Ks = (bf16_t*)smem;
    bf16_t* Vt = Ks + 64 * 72;
    bf16_t* Wl = Vt + 64 * 72;
    int* flags = (int*)(Wl + 4 * 16 * 72);
    const int tid = tid_(), lane = tid & 63, w = tid >> 6, fr = lane & 15, fq = lane >> 4;
    bf16_t* Ww = Wl + w * 16 * 72;
    int qrow_a, tbase, k0;
    if (!SAMPLE) { qrow_a = b * SEQ + qt * 64 + w * 16; tbase = qt * 64 + w * 16; k0 = qt * 64; }
    else { qrow_a = NPR + b * 16; tbase = PAST; k0 = PAST; }
    bf16x8 qf[2];
#pragma unroll
    for (int ks = 0; ks < 2; ++ks) qf[ks] = *(const bf16x8*)(p->CQ + (size_t)(qrow_a + fr) * 512 + h * 64 + ks * 32 + fq * 8);
    float R[4] = {0.f, 0.f, 0.f, 0.f};
    f32x4 O[4];
#pragma unroll
    for (int dt = 0; dt < 4; ++dt) O[dt] = (f32x4){0.f, 0.f, 0.f, 0.f};
    for (; k0 >= 0; k0 -= 64) {
        {
            const int key = tid >> 2, part = (tid & 3) * 16;
            u32x4 kr0, kr1, vr0, vr1;
            if (!SAMPLE) {
                const bf16_t* ks_ = p->CK + (size_t)(b * SEQ + k0 + key) * 512 + h * 64 + part;
                const bf16_t* vs_ = p->CV + (size_t)(b * SEQ + k0 + key) * 512 + h * 64 + part;
                kr0 = *(const u32x4*)ks_; kr1 = *(const u32x4*)(ks_ + 8);
                vr0 = *(const u32x4*)vs_; vr1 = *(const u32x4*)(vs_ + 8);
            } else {
                const int pos = k0 + key;
                const float *kp = nullptr, *vp = nullptr;
                if (pos < PAST) {
                    const size_t o = (((size_t)(l * 16 + b) * PAST + pos) * 8 + h) * 64 + part;
                    kp = p->cache_c_k + o; vp = p->cache_c_v + o;
                } else if (pos < PAST + 16) {
                    const size_t o = ((size_t)(l * NSM + b * 16 + pos - PAST) * 8 + h) * 64 + part;
                    kp = p->out + O_CKS + o; vp = p->out + O_CVS + o;
                }
                if (kp) {
                    const f32x4 a0 = *(const f32x4*)kp, a1 = *(const f32x4*)(kp + 4), a2 = *(const f32x4*)(kp + 8), a3 = *(const f32x4*)(kp + 12);
                    const f32x4 c0 = *(const f32x4*)vp, c1 = *(const f32x4*)(vp + 4), c2 = *(const f32x4*)(vp + 8), c3 = *(const f32x4*)(vp + 12);
                    kr0 = __builtin_bit_cast(u32x4, pack8(a0, a1)); kr1 = __builtin_bit_cast(u32x4, pack8(a2, a3));
                    vr0 = __builtin_bit_cast(u32x4, pack8(c0, c1)); vr1 = __builtin_bit_cast(u32x4, pack8(c2, c3));
                } else {
                    kr0 = kr1 = vr0 = vr1 = (u32x4){0u, 0u, 0u, 0u};
                }
            }
            *(u32x4*)(Ks + key * 72 + part) = kr0;
            *(u32x4*)(Ks + key * 72 + part + 8) = kr1;
#pragma unroll
            for (int c = 0; c < 4; ++c) {
                Vt[(part + 2 * c) * 72 + key] = (bf16_t)(vr0[c] & 0xffffu);
                Vt[(part + 2 * c + 1) * 72 + key] = (bf16_t)(vr0[c] >> 16);
                Vt[(part + 8 + 2 * c) * 72 + key] = (bf16_t)(vr1[c] & 0xffffu);
                Vt[(part + 8 + 2 * c + 1) * 72 + key] = (bf16_t)(vr1[c] >> 16);
            }
        }
        __syncthreads();
        float wv[4][4];
        float tot[4][4];
        float cs[4][4];
        float zz[4][4];
#pragma unroll
        for (int n = 0; n < 4; ++n) {
            f32x4 s = (f32x4){0.f, 0.f, 0.f, 0.f};
#pragma unroll
            for (int ks = 0; ks < 2; ++ks) {
                const bf16x8 kf = *(const bf16x8*)(Ks + (n * 16 + fr) * 72 + ks * 32 + fq * 8);
                s = mfma16(qf[ks], kf, s);
            }
            const int kpos = k0 + n * 16 + fr;
#pragma unroll
            for (int j = 0; j < 4; ++j) {
                const float z = s[j] * 0.125f;
                const bool mk = kpos < (tbase + fq * 4 + j);
                const float sp = fmaxf(z, 0.f) + __logf(1.0f + __expf(-fabsf(z)));
                float c = mk ? -sp : 0.f;
                zz[n][j] = z;
#pragma unroll
                for (int d = 1; d < 16; d <<= 1) { const float t = __shfl_down(c, d, 16); if (fr + d < 16) c += t; }
                cs[n][j] = c;
                tot[n][j] = __shfl(c, lane & 48);
            }
        }
#pragma unroll
        for (int j = 0; j < 4; ++j) {
            float add = R[j];
#pragma unroll
            for (int n = 3; n >= 0; --n) {
                const int kpos = k0 + n * 16 + fr;
                const bool mk = kpos < (tbase + fq * 4 + j);
                const float e = zz[n][j] + cs[n][j] + add;
                wv[n][j] = mk ? __expf(e) : 0.f;
                add += tot[n][j];
            }
            R[j] = add;
        }
#pragma unroll
        for (int n = 0; n < 4; ++n)
#pragma unroll
            for (int j = 0; j < 4; j += 2) {
                const unsigned pk = pk_bf16(wv[n][j], wv[n][j + 1]);
                Ww[(fq * 4 + j) * 72 + n * 16 + fr] = (bf16_t)(pk & 0xffffu);
                Ww[(fq * 4 + j + 1) * 72 + n * 16 + fr] = (bf16_t)(pk >> 16);
            }
        const bool mine = (R[0] < -30.f) && (R[1] < -30.f) && (R[2] < -30.f) && (R[3] < -30.f);
        const int alldone = __all(mine);
        if (lane == 0) flags[w] = alldone;
        __syncthreads();
#pragma unroll
        for (int ks = 0; ks < 2; ++ks) {
            const bf16x8 wf = *(const bf16x8*)(Ww + fr * 72 + ks * 32 + fq * 8);
#pragma unroll
            for (int dt = 0; dt < 4; ++dt) {
                const bf16x8 vf = *(const bf16x8*)(Vt + (dt * 16 + fr) * 72 + ks * 32 + fq * 8);
                O[dt] = mfma16(wf, vf, O[dt]);
            }
        }
        const int done = flags[0] & flags[1] & flags[2] & flags[3];
        __syncthreads();
        if (done) break;
    }
    if (!SAMPLE || w == 0) {
#pragma unroll
        for (int dt = 0; dt < 4; ++dt)
#pragma unroll
            for (int j = 0; j < 4; j += 2) {
                const unsigned pk = pk_bf16(O[dt][j], O[dt][j + 1]);
                p->OC[(size_t)(qrow_a + fq * 4 + j) * 512 + h * 64 + dt * 16 + fr] = (bf16_t)(pk & 0xffffu);
                p->OC[(size_t)(qrow_a + fq * 4 + j + 1) * 512 + h * 64 + dt * 16 + fr] = (bf16_t)(pk >> 16);
            }
    }
}

constexpr int NI_BS = NSM / 4, NI_BP = NPR / 4, NI_C = 2048 + 128, NI_A = 144 * 4;
constexpr int NI_TOTAL = NI_BS + NI_BP + NI_C + NI_A;
DEVI void phase_mixers(CP p, int l, unsigned char* smem, unsigned char* smem1, int* s_item) {
    const int tid = tid_();
    const int w = __builtin_amdgcn_readfirstlane(tid >> 6);
    unsigned char* wb = (w < 2) ? smem + w * 17664 : smem1 + (w - 2) * 17664;
    unsigned* wl = (unsigned*)wb;
    int* idxl = (int*)(wb + 16640);
    unsigned* ctr = p->bar + XCD_BAR_WORDS + 64 * l;
    if (tid == 0) *s_item = (int)__hip_atomic_fetch_add(ctr, 1u, __ATOMIC_RELAXED, __HIP_MEMORY_SCOPE_AGENT);
    __syncthreads();
    int item = __builtin_amdgcn_readfirstlane(*s_item);
    while (item < NI_TOTAL) {
        int nxt = 0;
        if (tid == 0) nxt = (int)__hip_atomic_fetch_add(ctr, 1u, __ATOMIC_RELAXED, __HIP_MEMORY_SCOPE_AGENT);
        if (item < NI_BS) {
            dsa_query<true>(p, l, NPR + item * 4 + w, wl, idxl);
        } else if (item < NI_BS + NI_BP) {
            const int k = item - NI_BS;
            const int bb = k >> 10, tt = 1023 - (k & 1023);
            dsa_query<false>(p, l, bb * SEQ + tt * 4 + w, wl, idxl);
        } else if (item < NI_BS + NI_BP + NI_C) {
            __syncthreads();
            const int u = item - NI_BS - NI_BP;
            if (u < 2048) { const int h = u & 7, qt = 63 - ((u >> 3) & 63), bb = u >> 9; stick_unit<false>(p, l, bb, h, qt, smem); }
            else { const int v = u - 2048; stick_unit<true>(p, l, v >> 3, v & 7, 0, smem); }
        } else {
            __syncthreads();
            const int u = item - NI_BS - NI_BP - NI_C;
            amix_unit(p, l, u >> 2, u & 3, smem);
        }
        __syncthreads();
        if (tid == 0) *s_item = nxt;
        __syncthreads();
        item = __builtin_amdgcn_readfirstlane(*s_item);
    }
}

template <int NT>
DEVI void phase_merge(CP p, int l, unsigned char* smem, unsigned char* smem1, int rt0, int nrt) {
    const int tid = tid_(), lane = tid & 63, wid = tid >> 6, wr = wid >> 1, wc = wid & 1, fr = lane & 15, fq = lane >> 4;
    constexpr int NCT = DM / (NT * 32);
    TileMap tm; tm.init(nrt, NCT);
    for (int v = tm.j; v < tm.total; v += tm.J) {
        int ct, rt; tm.get(v, rt, ct); rt += rt0;
        f32x4 mg[4][NT];
        zero_acc<NT>(mg);
        const int rbase = rt * 128 + wr * 64 + fr, cb = ct * (NT * 32) + wc * (NT * 16) + fq * 4;
#pragma unroll 1
        for (int br = 0; br < 3; ++br) {
            const bf16_t* A = (br == 0) ? p->OA : (br == 1) ? p->OB : p->OC;
            const bf16_t* W = ((br == 0) ? p->Wa : (br == 1) ? p->Wb : p->Wc) + (size_t)l * DM * 512;
            f32x4 acc[4][NT];
            zero_acc<NT>(acc);
            gemm_acc<NT>(acc, A + (size_t)rt * 128 * 512, 512, W + (size_t)ct * (NT * 32) * 512, 512, 512, smem, smem1);
#pragma unroll
            for (int m = 0; m < 4; ++m)
#pragma unroll
                for (int n = 0; n < NT; ++n) {
                    const u32x2 gg = *(const u32x2*)(p->G + (size_t)(rbase + m * 16) * 3072 + br * 1024 + cb + n * 16);
                    mg[m][n][0] += bf_lo(gg.x) * acc[m][n][0]; mg[m][n][1] += bf_hi(gg.x) * acc[m][n][1];
                    mg[m][n][2] += bf_lo(gg.y) * acc[m][n][2]; mg[m][n][3] += bf_hi(gg.y) * acc[m][n][3];
                }
        }
#pragma unroll
        for (int m = 0; m < 4; ++m)
#pragma unroll
            for (int n = 0; n < NT; ++n) st_bf4(p->MG + (size_t)(rbase + m * 16) * DM + cb + n * 16, mg[m][n]);
    }
}

template <int NT>
DEVI void phase_resid(CP p, const bf16_t* A, int K, const bf16_t* W, unsigned char* smem, unsigned char* smem1, int rt0, int nrt) {
    const int tid = tid_(), lane = tid & 63, wid = tid >> 6, wr = wid >> 1, wc = wid & 1, fr = lane & 15, fq = lane >> 4;
    constexpr int NCT = DM / (NT * 32);
    TileMap tm; tm.init(nrt, NCT);
    for (int v = tm.j; v < tm.total; v += tm.J) {
        int ct, rt; tm.get(v, rt, ct); rt += rt0;
        f32x4 acc[4][NT];
        zero_acc<NT>(acc);
        gemm_acc<NT>(acc, A + (size_t)rt * 128 * K, K, W + (size_t)ct * (NT * 32) * K, K, K, smem, smem1);
        const int rbase = rt * 128 + wr * 64 + fr, cb = ct * (NT * 32) + wc * (NT * 16) + fq * 4;
#pragma unroll
        for (int m = 0; m < 4; ++m)
#pragma unroll
            for (int n = 0; n < NT; ++n) {
                float* xp = p->X + (size_t)(rbase + m * 16) * DM + cb + n * 16;
                *(f32x4*)xp = *(const f32x4*)xp + acc[m][n];
            }
    }
}

DEVI void phase_ffn_in(CP p, int l, unsigned char* smem, unsigned char* smem1) {
    const int tid = tid_(), lane = tid & 63, wid = tid >> 6, wr = wid >> 1, wc = wid & 1, fr = lane & 15, fq = lane >> 4;
    constexpr int NCT = NFFI / 128, NRT = MT / 128;
    TileMap tm; tm.init(NRT, NCT);
    for (int v = tm.j; v < tm.total; v += tm.J) {
        int ct, rt; tm.get(v, rt, ct);
        f32x4 acc[4][4];
        zero_acc<4>(acc);
        gemm_acc<4>(acc, p->H + (size_t)rt * 128 * DM, DM, p->Wffi + ((size_t)l * NFFI + ct * 128) * DM, DM, DM, smem, smem1);
        const int rbase = rt * 128 + wr * 64 + fr, cb = ct * 64 + wc * 32 + fq * 4;
#pragma unroll
        for (int m = 0; m < 4; ++m)
#pragma unroll
            for (int n = 0; n < 2; ++n) {
                const f32x4 g = acc[m][n], up = acc[m][n + 2];
                f32x4 o;
#pragma unroll
                for (int j = 0; j < 4; ++j) o[j] = g[j] * sigmoidf_(g[j]) * up[j];
                st_bf4(p->ACT + (size_t)(rbase + m * 16) * DFF + cb + n * 16, o);
            }
    }
}

template <int NT>
DEVI void phase_ple(CP p, int l, unsigned char* smem, unsigned char* smem1, int rt0, int nrt) {
    const int tid = tid_(), lane = tid & 63, wid = tid >> 6, wr = wid >> 1, wc = wid & 1, fr = lane & 15, fq = lane >> 4;
    constexpr int NCT = DM / (NT * 32);
    TileMap tm; tm.init(nrt, NCT);
    for (int v = tm.j; v < tm.total; v += tm.J) {
        int ct, rt; tm.get(v, rt, ct); rt += rt0;
        f32x4 sg[4][NT];
        zero_acc<NT>(sg);
        gemm_acc<NT>(sg, p->H + (size_t)rt * 128 * DM, DM, p->Wpg + ((size_t)l * DM + ct * (NT * 32)) * DM, DM, DM, smem, smem1);
#pragma unroll
        for (int m = 0; m < 4; ++m)
#pragma unroll
            for (int n = 0; n < NT; ++n)
#pragma unroll
                for (int j = 0; j < 4; ++j) sg[m][n][j] = sigmoidf_(sg[m][n][j]);
        f32x4 acc[4][NT];
        zero_acc<NT>(acc);
        gemm_acc<NT>(acc, p->P + ((size_t)l * MT + rt * 128) * 256, 256, p->Wpp + ((size_t)l * DM + ct * (NT * 32)) * 256, 256, 256, smem, smem1);
        const int rbase = rt * 128 + wr * 64 + fr, cb = ct * (NT * 32) + wc * (NT * 16) + fq * 4;
#pragma unroll
        for (int m = 0; m < 4; ++m)
#pragma unroll
            for (int n = 0; n < NT; ++n) {
                const int row = rbase + m * 16;
                float* xp = p->X + (size_t)row * DM + cb + n * 16;
                const f32x4 r = *(const f32x4*)xp + sg[m][n] * acc[m][n];
                *(f32x4*)xp = r;
                if (l == 1) __builtin_nontemporal_store(r, (f32x4*)(p->out + (size_t)row * DM + cb + n * 16));
            }
    }
}

#define XB_TMO      128
#define XB_XCNT(j)  (256  + 64 * (j))
#define XB_XSUB(j)  (1280 + 64 * (j))
#define XB_XGEN(j)  (2304 + 64 * (j))
#define XB_TOP      3328
#define XB_TOPGEN   3392
#define XB_SPIN_CAP (1u << 18)
#define LAS __attribute__((address_space(3)))
DEVI unsigned xb_ld(unsigned* p) { return __hip_atomic_load(p, __ATOMIC_RELAXED, __HIP_MEMORY_SCOPE_AGENT); }
DEVI unsigned xb_add(unsigned* p, unsigned v) { return __hip_atomic_fetch_add(p, v, __ATOMIC_RELAXED, __HIP_MEMORY_SCOPE_AGENT); }
DEVI unsigned xb_xcc_id() { return (unsigned)__builtin_amdgcn_s_getreg((3 << 11) | 20) & 0xFu; }
#define XB_SPIN(cond, bar) do { unsigned _sp = 0; while (cond) { __builtin_amdgcn_s_sleep(1); \
    if ((++_sp & 255u) == 0u) { if (xb_ld(&(bar)[XB_TMO])) break; if (_sp > XB_SPIN_CAP) { atomicAdd(&(bar)[XB_TMO], 1u); break; } } } } while (0)
struct XcdBarrier { unsigned* bar; unsigned x; volatile LAS unsigned* st; };
DEVI XcdBarrier xcd_barrier_post(unsigned* bar, volatile LAS unsigned* st) {
    XcdBarrier b; b.bar = bar; b.x = xb_xcc_id(); b.st = st;
    if (__builtin_amdgcn_workitem_id_x() == 0) (void)xb_add(&bar[XB_XCNT(b.x)], 1u);
    return b;
}
DEVI void xcd_barrier_complete(unsigned* bar, unsigned x, unsigned& nloc, unsigned& nx) {
    const unsigned G = gridDim.x * gridDim.y * gridDim.z;
    unsigned sum, cnt, mine, sp = 0u;
    for (;;) {
        sum = 0u; cnt = 0u; mine = 0u;
#pragma unroll
        for (unsigned j = 0; j < 16; ++j) { const unsigned c = xb_ld(&bar[XB_XCNT(j)]); sum += c; cnt += (c > 0u) ? 1u : 0u; mine = (j == x) ? c : mine; }
        if (sum == G) break;
        __builtin_amdgcn_s_sleep(1);
        if ((++sp & 255u) == 0u) { if (xb_ld(&bar[XB_TMO])) break; if (sp > XB_SPIN_CAP) { atomicAdd(&bar[XB_TMO], 1u); break; } }
    }
    nloc = mine > 0u ? mine : 1u; nx = cnt > 0u ? cnt : 1u;
}
DEVI void xcd_barrier(const XcdBarrier& b) {
    asm volatile("s_waitcnt vmcnt(0)" ::: "memory");
    __syncthreads();
    if (__builtin_amdgcn_workitem_id_x() == 0) {
        unsigned* bar = b.bar;
        __builtin_amdgcn_s_waitcnt(0);
        unsigned nloc = b.st[0], nx = b.st[1];
        if (nloc == 0u) { xcd_barrier_complete(bar, b.x, nloc, nx); b.st[0] = nloc; b.st[1] = nx; }
        const unsigned old = xb_add(&bar[XB_XSUB(b.x)], 1u);
        const unsigned gen = old / nloc;
        if (old + 1u == (gen + 1u) * nloc) {
            __builtin_amdgcn_fence(__ATOMIC_RELEASE, "agent");
            asm volatile("s_waitcnt vmcnt(0)" ::: "memory");
            const unsigned og = xb_add(&bar[XB_TOP], 1u);
            const unsigned tg = og / nx;
            if (og + 1u == (tg + 1u) * nx) xb_add(&bar[XB_TOPGEN], 1u);
            else XB_SPIN(xb_ld(&bar[XB_TOPGEN]) == tg, bar);
            __builtin_amdgcn_fence(__ATOMIC_ACQUIRE, "agent");
            xb_add(&bar[XB_XGEN(b.x)], 1u);
            asm volatile("s_waitcnt vmcnt(0)" ::: "memory");
        } else {
            XB_SPIN(xb_ld(&bar[XB_XGEN(b.x)]) == gen, bar);
            __builtin_amdgcn_fence(__ATOMIC_ACQUIRE, "agent");
            asm volatile("s_waitcnt vmcnt(0)" ::: "memory");
        }
    }
    __syncthreads();
}

__global__ void __launch_bounds__(256, 2) mega(Params p_by_value) {
    cg::grid_group grid = cg::this_grid();
    __shared__ __attribute__((aligned(16))) unsigned char smem[SMEM_HALF];
    __shared__ __attribute__((aligned(16))) unsigned char smem1[SMEM_HALF];
    __shared__ uint4 xb_words;
    __shared__ int s_item[4];
    if (__builtin_amdgcn_workitem_id_x() == 0) xb_words = make_uint4(0u, 0u, 0u, 0u);
    __syncthreads();
    CP p = (CP)__builtin_amdgcn_kernarg_segment_ptr();
    if (launder(p)->out == nullptr) grid.sync();
    XcdBarrier xb = xcd_barrier_post(launder(p)->bar, (volatile LAS unsigned*)&xb_words);
    phase0(launder(p), smem);
    xcd_barrier(xb);
    for (int l = 0; l < 2; ++l) {
        if (l > 0) { CP q = launder(p); norm_phase(q->X, q->X + (size_t)NPR * DM, q->norm_mix + l * DM, q->H, nullptr); xcd_barrier(xb); }
        phase_gemm_in(launder(p), l, smem, smem1);
        xcd_barrier(xb);
        phase_mixers(launder(p), l, smem, smem1, s_item);
        xcd_barrier(xb);
        phase_merge<4>(launder(p), l, smem, smem1, 0, 128);
        phase_merge<1>(launder(p), l, smem, smem1, 128, 2);
        xcd_barrier(xb);
        { CP q = launder(p); phase_resid<4>(q, q->MG, DM, q->Wout + (size_t)l * DM * DM, smem, smem1, 0, 128); }
        { CP q = launder(p); phase_resid<1>(q, q->MG, DM, q->Wout + (size_t)l * DM * DM, smem, smem1, 128, 2); }
        xcd_barrier(xb);
        { CP q = launder(p); norm_phase(q->X, q->X + (size_t)NPR * DM, q->norm_ffn + l * DM, q->H, nullptr); }
        xcd_barrier(xb);
        phase_ffn_in(launder(p), l, smem, smem1);
        xcd_barrier(xb);
        { CP q = launder(p); phase_resid<4>(q, q->ACT, DFF, q->Wffo + (size_t)l * DM * DFF, smem, smem1, 0, 128); }
        { CP q = launder(p); phase_resid<1>(q, q->ACT, DFF, q->Wffo + (size_t)l * DM * DFF, smem, smem1, 128, 2); }
        xcd_barrier(xb);
        { CP q = launder(p); norm_phase(q->X, q->X + (size_t)NPR * DM, q->norm_ple + l * DM, q->H, nullptr); }
        xcd_barrier(xb);
        phase_ple<4>(launder(p), l, smem, smem1, 0, 128);
        phase_ple<1>(launder(p), l, smem, smem1, 128, 2);
        if (l == 0) xcd_barrier(xb);
    }
}

extern "C" void kernel_launch(void* const* d_in, const int* in_sizes, int n_in, void* d_out, int out_size, void* d_ws, size_t ws_size, hipStream_t stream) {
    static int grid_blocks = 0;
    if (!grid_blocks) {
        int dev = 0, cus = 0, per_cu = 0;
        hipGetDevice(&dev);
        hipDeviceGetAttribute(&cus, hipDeviceAttributeMultiprocessorCount, dev);
        hipOccupancyMaxActiveBlocksPerMultiprocessor(&per_cu, mega, 256, 0);
        if (per_cu > 2) per_cu = 2;
        if (per_cu < 1) per_cu = 1;
        grid_blocks = cus * per_cu;
    }
    Params hp{};
    const float** fin = (const float**)&hp;
    for (int i = 0; i < 27; ++i) fin[i] = (const float*)d_in[i];
    hp.out = (float*)d_out;
    unsigned char* ws = (unsigned char*)d_ws;
    size_t off = 0;
    auto take = [&](size_t bytes) { void* r = ws + off; off += (bytes + 255) & ~(size_t)255; return r; };
    hp.Win = (bf16_t*)take((size_t)2 * NIN * DM * 2);
    hp.Wa = (bf16_t*)take((size_t)2 * DM * 512 * 2);
    hp.Wb = (bf16_t*)take((size_t)2 * DM * 512 * 2);
    hp.Wc = (bf16_t*)take((size_t)2 * DM * 512 * 2);
    hp.Wout = (bf16_t*)take((size_t)2 * DM * DM * 2);
    hp.Wffi = (bf16_t*)take((size_t)2 * NFFI * DM * 2);
    hp.Wffo = (bf16_t*)take((size_t)2 * DM * DFF * 2);
    hp.Wpg = (bf16_t*)take((size_t)2 * DM * DM * 2);
    hp.Wpp = (bf16_t*)take((size_t)2 * DM * 256 * 2);
    hp.WS = (bf16_t*)take((size_t)2 * 4 * 128 * 128 * 2);
    hp.X = (float*)take((size_t)MT * DM * 4);
    hp.H = (bf16_t*)take((size_t)MT * DM * 2);
    hp.AU = (bf16_t*)take((size_t)MT * 512 * 2);
    hp.AVp = (bf16_t*)take((size_t)MT * 512 * 2);
    hp.BQ = (bf16_t*)take((size_t)MT * 512 * 2);
    hp.BK = (bf16_t*)take((size_t)MT * 128 * 2);
    hp.BV = (bf16_t*)take((size_t)MT * 128 * 2);
    hp.IQ = (bf16_t*)take((size_t)MT * 256 * 2);
    hp.IK = (bf16_t*)take((size_t)MT * 32 * 2);
    hp.IW = (float*)take((size_t)MT * 8 * 4);
    hp.CQ = (bf16_t*)take((size_t)MT * 512 * 2);
    hp.CK = (bf16_t*)take((size_t)MT * 512 * 2);
    hp.CV = (bf16_t*)take((size_t)MT * 512 * 2);
    hp.G = (bf16_t*)take((size_t)MT * 3072 * 2);
    hp.OA = (bf16_t*)take((size_t)MT * 512 * 2);
    hp.OB = (bf16_t*)take((size_t)MT * 512 * 2);
    hp.OC = (bf16_t*)take((size_t)MT * 512 * 2);
    hp.MG = (bf16_t*)take((size_t)MT * DM * 2);
    hp.ACT = (bf16_t*)take((size_t)MT * DFF * 2);
    hp.P = (bf16_t*)take((size_t)2 * MT * 256 * 2);
    hp.bar = (unsigned*)take((size_t)(XCD_BAR_WORDS + 256) * 4);
    hipMemsetAsync(hp.bar, 0, (size_t)(XCD_BAR_WORDS + 256) * 4, stream);
    void* args[] = {&hp};
    hipError_t e = hipLaunchCooperativeKernel((void*)mega, dim3(grid_blocks), dim3(256), args, 0, stream);
    if (e != hipSuccess) fprintf(stderr, "cooperative launch failed: %s (grid %d)\n", hipGetErrorString(e), grid_blocks);
}
```

```cpp
#include <hip/hip_runtime.h>
#include <hip/hip_cooperative_groups.h>
#include <stdint.h>
#include <cstdio>
namespace cg = cooperative_groups;

typedef unsigned short bf16_t;
typedef short bf16x8 __attribute__((ext_vector_type(8)));
typedef float f32x4 __attribute__((ext_vector_type(4)));
typedef unsigned u32x4 __attribute__((ext_vector_type(4)));
typedef unsigned u32x2 __attribute__((ext_vector_type(2)));
#define DEVI __device__ __forceinline__

constexpr int DM = 1024, NPR = 16384, NSM = 256, MT = NPR + NSM, SEQ = 4096, PAST = 4096;
constexpr int NIN = 6784, INSRC = 6696, DFF = 2816, NFFI = 5632;
constexpr float EPS = 1e-6f;
constexpr int O_YP = 0;
constexpr int O_YS = O_YP + NPR * DM;
constexpr int O_BKP = O_YS + NSM * DM;
constexpr int O_BVP = O_BKP + 2 * NPR * 128;
constexpr int O_IKP = O_BVP + 2 * NPR * 128;
constexpr int O_CKP = O_IKP + 2 * NPR * 32;
constexpr int O_CVP = O_CKP + 2 * NPR * 512;
constexpr int O_BKS = O_CVP + 2 * NPR * 512;
constexpr int O_BVS = O_BKS + 2 * NSM * 128;
constexpr int O_IKS = O_BVS + 2 * NSM * 128;
constexpr int O_CKS = O_IKS + 2 * NSM * 32;
constexpr int O_CVS = O_CKS + 2 * NSM * 512;
constexpr int O_AVS = O_CVS + 2 * NSM * 512;

constexpr int SMEM_HALF = 35328;
#define XCD_BAR_WORDS 3456

struct Params {
    const float *x_prompt, *x_sample, *cache_b_k, *cache_b_v, *cache_b_kidx, *cache_c_k, *cache_c_v, *p_prompt, *p_sample;
    const float *norm_mix, *w_in, *gate_bias, *a_vnorm, *a_ws, *a_bias, *b_qnorm, *b_knorm, *w_br_a, *w_br_b, *w_br_c, *w_out;
    const float *norm_ffn, *w_ffn_in, *w_ffn_out, *norm_ple, *w_ple_gate, *w_ple_proj;
    float* out;
    bf16_t *Win, *Wa, *Wb, *Wc, *Wout, *Wffi, *Wffo, *Wpg, *Wpp, *WS;
    float* X;
    bf16_t *H, *AU, *AVp, *BQ, *BK, *BV, *IQ, *IK;
    float* IW;
    bf16_t *CQ, *CK, *CV, *G, *OA, *OB, *OC, *MG, *ACT, *P;
    unsigned* bar;
};

typedef const __attribute__((address_space(4))) Params* CP;
DEVI CP launder(CP q) { asm volatile("" : "+s"(q)); return q; }

DEVI int tid_() { int t = __builtin_amdgcn_workitem_id_x(); asm volatile("" : "+v"(t)); return t; }
typedef float f32x2_t __attribute__((ext_vector_type(2)));
typedef __bf16 bf16x2_t __attribute__((ext_vector_type(2)));
DEVI unsigned pk_bf16(float lo, float hi) { const f32x2_t v = {lo, hi}; return __builtin_bit_cast(unsigned, __builtin_convertvector(v, bf16x2_t)); }
DEVI float bf_lo(unsigned u) { return __uint_as_float(u << 16); }
DEVI float bf_hi(unsigned u) { return __uint_as_float(u & 0xffff0000u); }
DEVI void st_bf4(bf16_t* dst, f32x4 v) { u32x2 w; w.x = pk_bf16(v[0], v[1]); w.y = pk_bf16(v[2], v[3]); *(u32x2*)dst = w; }
DEVI float sigmoidf_(float x) { return __builtin_amdgcn_rcpf(1.0f + __expf(-x)); }
DEVI float gelu_tanh(float x) { float u = 0.7978845608028654f * (x + 0.044715f * x * x * x); return x * sigmoidf_(2.0f * u); }
DEVI f32x4 mfma16(bf16x8 a, bf16x8 b, f32x4 c) { return __builtin_amdgcn_mfma_f32_16x16x32_bf16(a, b, c, 0, 0, 0); }
DEVI bf16x8 pack8(f32x4 a, f32x4 b) {
    u32x4 w; w.x = pk_bf16(a[0], a[1]); w.y = pk_bf16(a[2], a[3]); w.z = pk_bf16(b[0], b[1]); w.w = pk_bf16(b[2], b[3]);
    return __builtin_bit_cast(bf16x8, w);
}
DEVI bf16x8 zero8() { u32x4 w = {0u, 0u, 0u, 0u}; return __builtin_bit_cast(bf16x8, w); }
DEVI void wave_sync() {
    __builtin_amdgcn_fence(__ATOMIC_RELEASE, "wavefront");
    __builtin_amdgcn_wave_barrier();
    __builtin_amdgcn_fence(__ATOMIC_ACQUIRE, "wavefront");
}
DEVI float wave_sum(float v) {
#pragma unroll
    for (int o = 1; o < 64; o <<= 1) v += __shfl_xor(v, o);
    return v;
}
DEVI float wave_max(float v) {
#pragma unroll
    for (int o = 1; o < 64; o <<= 1) v = fmaxf(v, __shfl_xor(v, o));
    return v;
}
DEVI int wave_sum_i(int v) {
#pragma unroll
    for (int o = 1; o < 64; o <<= 1) v += __shfl_xor(v, o);
    return v;
}
DEVI int wave_min_i(int v) {
#pragma unroll
    for (int o = 1; o < 64; o <<= 1) { const int t = __shfl_xor(v, o); v = t < v ? t : v; }
    return v;
}
DEVI float* state_out(float* out, int offP, int offS, int l, int row, int W) {
    return (row < NPR) ? out + offP + (size_t)(l * NPR + row) * W : out + offS + (size_t)(l * NSM + (row - NPR)) * W;
}

typedef __attribute__((address_space(3))) unsigned char* LdsP;
template <int NT>
DEVI void gemm_acc(f32x4 (&acc)[4][NT], const bf16_t* __restrict__ A, int lda, const bf16_t* __restrict__ Bt, int ldb, int K, unsigned char* smem0, unsigned char* smem1) {
    const int tid = tid_(), lane = tid & 63, wid = __builtin_amdgcn_readfirstlane(tid >> 6), wr = wid >> 1, wc = wid & 1, fr = lane & 15, fq = lane >> 4;
    LdsP lds0 = (LdsP)smem0;
    LdsP lds1 = (LdsP)smem1;
    constexpr int ABYTES = 128 * 128;
    const int csw = (lane & 7) ^ (((wid & 1) << 2) | (lane >> 4));
    const int rl = wid * 8 + (lane >> 3);
    const bf16_t* Ag = A + (size_t)rl * lda + csw * 8;
    const bf16_t* Bg = Bt + (size_t)rl * ldb + csw * 8;
    const int sw = fr >> 1;
    const int aoff = (wr * 64 + fr) * 128;
    const int boff = ABYTES + (wc * (NT * 16) + fr) * 128;
    const int nk = K >> 6;
    __syncthreads();
#define GEMM_ISSUE(kt_, L_) do { \
        _Pragma("unroll") for (int i_ = 0; i_ < 4; ++i_) \
            __builtin_amdgcn_global_load_lds((const unsigned*)(Ag + (size_t)(32 * i_) * lda + (kt_) * 64), (__attribute__((address_space(3))) unsigned*)((L_) + wid * 1024 + i_ * 4096), 16, 0, 0); \
        _Pragma("unroll") for (int i_ = 0; i_ < NT; ++i_) \
            __builtin_amdgcn_global_load_lds((const unsigned*)(Bg + (size_t)(32 * i_) * ldb + (kt_) * 64), (__attribute__((address_space(3))) unsigned*)((L_) + ABYTES + wid * 1024 + i_ * 4096), 16, 0, 0); \
    } while (0)
#define GEMM_COMPUTE(L_) do { \
        _Pragma("unroll") for (int ks = 0; ks < 2; ++ks) { \
            const int co = ((ks * 4 + fq) ^ sw) << 4; \
            bf16x8 af[4], bfr[NT]; \
            _Pragma("unroll") for (int m = 0; m < 4; ++m) af[m] = *(const __attribute__((address_space(3))) bf16x8*)((L_) + aoff + m * 2048 + co); \
            _Pragma("unroll") for (int n = 0; n < NT; ++n) bfr[n] = *(const __attribute__((address_space(3))) bf16x8*)((L_) + boff + n * 2048 + co); \
            __builtin_amdgcn_s_setprio(1); \
            _Pragma("unroll") for (int m = 0; m < 4; ++m) \
                _Pragma("unroll") for (int n = 0; n < NT; ++n) acc[m][n] = mfma16(bfr[n], af[m], acc[m][n]); \
            __builtin_amdgcn_s_setprio(0); \
        } } while (0)
    GEMM_ISSUE(0, lds0);
    for (int kt = 0; kt < nk; kt += 2) {
        asm volatile("s_waitcnt vmcnt(0)" ::: "memory");
        __syncthreads();
        GEMM_ISSUE(kt + 1, lds1);
        GEMM_COMPUTE(lds0);
        asm volatile("s_waitcnt vmcnt(0)" ::: "memory");
        __syncthreads();
        if (kt + 2 < nk) GEMM_ISSUE(kt + 2, lds0);
        GEMM_COMPUTE(lds1);
    }
#undef GEMM_ISSUE
#undef GEMM_COMPUTE
}
template <int NT>
DEVI void zero_acc(f32x4 (&acc)[4][NT]) {
#pragma unroll
    for (int m = 0; m < 4; ++m)
#pragma unroll
        for (int n = 0; n < NT; ++n) acc[m][n] = (f32x4){0.f, 0.f, 0.f, 0.f};
}

struct TileMap {
    int x, j, J, nct, rows, full, remr, total;
    DEVI void init(int nrt, int nct_) {
        const int G = gridDim.x;
        nct = nct_;
        if ((G & 7) == 0) { x = blockIdx.x & 7; j = blockIdx.x >> 3; J = G >> 3; rows = (nrt - x + 7) >> 3; }
        else { x = -1; j = blockIdx.x; J = G; rows = nrt; }
        full = rows >> 3; remr = rows & 7; total = rows * nct;
    }
    DEVI void get(int v, int& rt, int& ct) const {
        int g = v / (8 * nct), ri;
        if (g < full) { const int rem = v - g * 8 * nct; ct = rem >> 3; ri = rem & 7; }
        else { g = full; const int rem = v - full * 8 * nct; ct = rem / remr; ri = rem - ct * remr; }
        const int lr = g * 8 + ri;
        rt = (x >= 0) ? x + 8 * lr : lr;
    }
};

DEVI int map_col(int mode, int n) {
    if (mode == 0) return n;
    if (mode == 1) { if (n < 2088) return n; if (n < 2176) return -1; return n - 88; }
    const int T = n >> 7, wc = (n >> 6) & 1, nn = (n >> 4) & 3, i = n & 15;
    return (nn >> 1) * DFF + T * 64 + wc * 32 + (nn & 1) * 16 + i;
}
DEVI void conv_tile(const float* __restrict__ W, int Nsrc, int K, bf16_t* __restrict__ Bt, int mode, int tn, int tk, float* tile) {
    const int tid = tid_();
    {
        const int kk = tid >> 4, n4 = (tid & 15) * 4;
        const int src = map_col(mode, tn * 64 + n4);
        f32x4 v[8];
#pragma unroll
        for (int ps = 0; ps < 8; ++ps) {
            v[ps] = (f32x4){0.f, 0.f, 0.f, 0.f};
            if (src >= 0) v[ps] = __builtin_nontemporal_load((const f32x4*)(W + (size_t)(tk * 128 + ps * 16 + kk) * Nsrc + src));
        }
#pragma unroll
        for (int ps = 0; ps < 8; ++ps) {
            const int k = ps * 16 + kk;
            tile[k * 65 + n4 + 0] = v[ps][0]; tile[k * 65 + n4 + 1] = v[ps][1]; tile[k * 65 + n4 + 2] = v[ps][2]; tile[k * 65 + n4 + 3] = v[ps][3];
        }
    }
    __syncthreads();
    {
        const int n = tid & 63, kc = (tid >> 6) * 32;
        bf16_t* dst = Bt + (size_t)(tn * 64 + n) * K + tk * 128 + kc;
#pragma unroll
        for (int q = 0; q < 4; ++q) {
            u32x4 w;
            w.x = pk_bf16(tile[(kc + q * 8 + 0) * 65 + n], tile[(kc + q * 8 + 1) * 65 + n]);
            w.y = pk_bf16(tile[(kc + q * 8 + 2) * 65 + n], tile[(kc + q * 8 + 3) * 65 + n]);
            w.z = pk_bf16(tile[(kc + q * 8 + 4) * 65 + n], tile[(kc + q * 8 + 5) * 65 + n]);
            w.w = pk_bf16(tile[(kc + q * 8 + 6) * 65 + n], tile[(kc + q * 8 + 7) * 65 + n]);
            *(u32x4*)(dst + q * 8) = w;
        }
    }
    __syncthreads();
}

DEVI void norm_phase(const float* __restrict__ srcP, const float* __restrict__ srcS, const float* __restrict__ gain, bf16_t* __restrict__ H, float* __restrict__ Xcopy) {
    const int lane = tid_() & 63;
    const int gw = blockIdx.x * 4 + (tid_() >> 6), nw = gridDim.x * 4;
    f32x4 g4[4];
#pragma unroll
    for (int i = 0; i < 4; ++i) g4[i] = *(const f32x4*)(gain + i * 256 + lane * 4);
    for (int r = gw; r < MT; r += nw) {
        const float* src = (r < NPR) ? srcP + (size_t)r * DM : srcS + (size_t)(r - NPR) * DM;
        f32x4 v[4];
        float ss = 0.f;
#pragma unroll
        for (int i = 0; i < 4; ++i) { v[i] = *(const f32x4*)(src + i * 256 + lane * 4); ss += v[i][0] * v[i][0] + v[i][1] * v[i][1] + v[i][2] * v[i][2] + v[i][3] * v[i][3]; }
        ss = wave_sum(ss);
        const float rstd = rsqrtf(ss * (1.0f / DM) + EPS);
#pragma unroll
        for (int i = 0; i < 4; ++i) {
            st_bf4(H + (size_t)r * DM + i * 256 + lane * 4, v[i] * rstd * g4[i]);
            if (Xcopy) *(f32x4*)(Xcopy + (size_t)r * DM + i * 256 + lane * 4) = v[i];
        }
    }
}

DEVI void phase0(CP p, unsigned char* smem) {
    float* tile = (float*)smem;
    {
        constexpr int T0 = 848, T1 = T0 + 704, T2 = T1 + 352, T3 = T2 + 128, T4 = T3 + 128, T5 = T4 + 64, T6 = T5 + 64, T7 = T6 + 64, T8 = T7 + 32;
        for (int u = blockIdx.x; u < 2 * T8; u += gridDim.x) {
            const int l = u / T8, r = u - l * T8;
            if (r < T0)      { const int t = r;      conv_tile(p->w_in + (size_t)l * DM * INSRC, INSRC, DM, p->Win + (size_t)l * NIN * DM, 1, t % 106, t / 106, tile); }
            else if (r < T1) { const int t = r - T0; conv_tile(p->w_ffn_in + (size_t)l * DM * NFFI, NFFI, DM, p->Wffi + (size_t)l * NFFI * DM, 2, t % 88, t / 88, tile); }
            else if (r < T2) { const int t = r - T1; conv_tile(p->w_ffn_out + (size_t)l * DFF * DM, DM, DFF, p->Wffo + (size_t)l * DM * DFF, 0, t % 16, t / 16, tile); }
            else if (r < T3) { const int t = r - T2; conv_tile(p->w_out + (size_t)l * DM * DM, DM, DM, p->Wout + (size_t)l * DM * DM, 0, t % 16, t / 16, tile); }
            else if (r < T4) { const int t = r - T3; conv_tile(p->w_ple_gate + (size_t)l * DM * DM, DM, DM, p->Wpg + (size_t)l * DM * DM, 0, t % 16, t / 16, tile); }
            else if (r < T5) { const int t = r - T4; conv_tile(p->w_br_a + (size_t)l * 512 * DM, DM, 512, p->Wa + (size_t)l * DM * 512, 0, t % 16, t / 16, tile); }
            else if (r < T6) { const int t = r - T5; conv_tile(p->w_br_b + (size_t)l * 512 * DM, DM, 512, p->Wb + (size_t)l * DM * 512, 0, t % 16, t / 16, tile); }
            else if (r < T7) { const int t = r - T6; conv_tile(p->w_br_c + (size_t)l * 512 * DM, DM, 512, p->Wc + (size_t)l * DM * 512, 0, t % 16, t / 16, tile); }
            else             { const int t = r - T7; conv_tile(p->w_ple_proj + (size_t)l * 256 * DM, DM, 256, p->Wpp + (size_t)l * DM * 256, 0, t % 16, t / 16, tile); }
        }
    }
    const int gt = blockIdx.x * 256 + tid_(), nt = gridDim.x * 256;
    for (int e = gt; e < 2 * 4 * 128 * 128; e += nt) {
        const int j = e & 127, i = (e >> 7) & 127;
        const float v = ((j >> 6) <= (i >> 6)) ? p->a_ws[e] : 0.f;
        p->WS[e] = (bf16_t)(pk_bf16(v, 0.f) & 0xffffu);
    }
    for (int e = gt; e < 2 * MT * 64; e += nt) {
        const int c4 = (e & 63) * 4, r = (e >> 6) % MT, l = (e >> 6) / MT;
        const float* src = (r < NPR) ? p->p_prompt + ((size_t)(l * NPR + r)) * 256 + c4 : p->p_sample + ((size_t)(l * NSM + r - NPR)) * 256 + c4;
        st_bf4(p->P + ((size_t)(l * MT + r)) * 256 + c4, __builtin_nontemporal_load((const f32x4*)src));
    }
    norm_phase(p->x_prompt, p->x_sample, p->norm_mix, p->H, nullptr);
}

DEVI void phase_gemm_in(CP p, int l, unsigned char* smem, unsigned char* smem1) {
    const int tid = tid_(), lane = tid & 63, wid = tid >> 6, wr = wid >> 1, wc = wid & 1, fr = lane & 15, fq = lane >> 4;
    constexpr int NCT = NIN / 128;
    TileMap tm; tm.init(NPR / 128, NCT);
    const int nmain = (tm.total - tm.j + tm.J - 1) / tm.J;
    int extra = -1;
    if (tm.x >= 0) { const int j0 = tm.total % tm.J; if (tm.j >= j0) { const int k = (tm.j - j0) * 8 + tm.x; if (k < 2 * NCT) extra = k; } }
    else tm.init(MT / 128, NCT);
    const int nmain2 = (tm.total - tm.j + tm.J - 1) / tm.J;
    const int niter = (tm.x >= 0 ? nmain : nmain2) + (extra >= 0 ? 1 : 0);
    for (int it = 0; it < niter; ++it) {
        int ct, rt;
        if (extra < 0 || it + 1 < niter) tm.get(tm.j + it * tm.J, rt, ct);
        else { rt = NPR / 128 + extra / NCT; ct = extra % NCT; }
        f32x4 acc[4][4];
        zero_acc<4>(acc);
        gemm_acc<4>(acc, p->H + (size_t)rt * 128 * DM, DM, p->Win + ((size_t)l * NIN + ct * 128) * DM, DM, DM, smem, smem1);
        const int rbase = rt * 128 + wr * 64 + fr;
        const int cw = wc * 64 + fq * 4;
        if (ct < 8) {
            bf16_t* dst = (ct < 4) ? p->AU : p->AVp;
            const int cb = (ct & 3) * 128 + cw;
#pragma unroll
            for (int m = 0; m < 4; ++m)
#pragma unroll
                for (int n = 0; n < 4; ++n) {
                    f32x4 v = acc[m][n];
                    v[0] = gelu_tanh(v[0]); v[1] = gelu_tanh(v[1]); v[2] = gelu_tanh(v[2]); v[3] = gelu_tanh(v[3]);
                    st_bf4(dst + (size_t)(rbase + m * 16) * 512 + cb + n * 16, v);
                }
        } else if (ct < 13) {
            const float* gn = (ct < 12) ? p->b_qnorm + l * 64 : p->b_knorm + l * 64;
            f32x4 g4[4];
#pragma unroll
            for (int n = 0; n < 4; ++n) g4[n] = *(const f32x4*)(gn + n * 16 + fq * 4);
#pragma unroll
            for (int m = 0; m < 4; ++m) {
                float ss = 0.f;
#pragma unroll
                for (int n = 0; n < 4; ++n) { const f32x4 v = acc[m][n]; ss += v[0] * v[0] + v[1] * v[1] + v[2] * v[2] + v[3] * v[3]; }
                ss += __shfl_xor(ss, 16); ss += __shfl_xor(ss, 32);
                const float rstd = rsqrtf(ss * (1.0f / 64.0f) + EPS);
                const int row = rbase + m * 16;
#pragma unroll
                for (int n = 0; n < 4; ++n) {
                    const f32x4 v = acc[m][n] * rstd * g4[n];
                    if (ct < 12) st_bf4(p->BQ + (size_t)row * 512 + (ct - 8) * 128 + cw + n * 16, v);
                    else {
                        st_bf4(p->BK + (size_t)row * 128 + cw + n * 16, v);
                        __builtin_nontemporal_store(v, (f32x4*)(state_out(p->out, O_BKP, O_BKS, l, row, 128) + cw + n * 16));
                    }
                }
            }
        } else if (ct == 13) {
#pragma unroll
            for (int m = 0; m < 4; ++m)
#pragma unroll
                for (int n = 0; n < 4; ++n) {
                    const int row = rbase + m * 16;
                    st_bf4(p->BV + (size_t)row * 128 + cw + n * 16, acc[m][n]);
                    __builtin_nontemporal_store(acc[m][n], (f32x4*)(state_out(p->out, O_BVP, O_BVS, l, row, 128) + cw + n * 16));
                }
        } else if (ct < 16) {
#pragma unroll
            for (int m = 0; m < 4; ++m)
#pragma unroll
                for (int n = 0; n < 4; ++n) st_bf4(p->IQ + (size_t)(rbase + m * 16) * 256 + (ct - 14) * 128 + cw + n * 16, acc[m][n]);
        } else if (ct == 16) {
#pragma unroll
            for (int m = 0; m < 4; ++m)
#pragma unroll
                for (int n = 0; n < 4; ++n) {
                    const int row = rbase + m * 16, c = cw + n * 16;
                    if (c < 32) {
                        st_bf4(p->IK + (size_t)row * 32 + c, acc[m][n]);
                        __builtin_nontemporal_store(acc[m][n], (f32x4*)(state_out(p->out, O_IKP, O_IKS, l, row, 32) + c));
                    } else if (c < 40) {
                        *(f32x4*)(p->IW + (size_t)row * 8 + (c - 32)) = acc[m][n] * 0.35355339059327373f;
                    }
                }
        } else if (ct < 29) {
            const int seg = (ct - 17) >> 2, cb = ((ct - 17) & 3) * 128 + cw;
            bf16_t* dst = (seg == 0) ? p->CQ : (seg == 1) ? p->CK : p->CV;
#pragma unroll
            for (int m = 0; m < 4; ++m)
#pragma unroll
                for (int n = 0; n < 4; ++n) {
                    const int row = rbase + m * 16;
                    st_bf4(dst + (size_t)row * 512 + cb + n * 16, acc[m][n]);
                    if (seg == 1) __builtin_nontemporal_store(acc[m][n], (f32x4*)(state_out(p->out, O_CKP, O_CKS, l, row, 512) + cb + n * 16));
                    if (seg == 2) __builtin_nontemporal_store(acc[m][n], (f32x4*)(state_out(p->out, O_CVP, O_CVS, l, row, 512) + cb + n * 16));
                }
        } else {
            const int cb = (ct - 29) * 128 + cw;
#pragma unroll
            for (int n = 0; n < 4; ++n) {
                const f32x4 gb = *(const f32x4*)(p->gate_bias + l * 3072 + cb + n * 16);
#pragma unroll
                for (int m = 0; m < 4; ++m) {
                    f32x4 v = acc[m][n] + gb;
                    v[0] = sigmoidf_(v[0]); v[1] = sigmoidf_(v[1]); v[2] = sigmoidf_(v[2]); v[3] = sigmoidf_(v[3]);
                    st_bf4(p->G + (size_t)(rbase + m * 16) * 3072 + cb + n * 16, v);
                }
            }
        }
    }
}

DEVI void amix_unit(CP p, int l, int ch, int g, unsigned char* smem) {
    bf16_t* Vt = (bf16_t*)smem;
    float* rs = (float*)(smem + 128 * 136 * 2);
    const int tid = tid_(), lane = tid & 63, w = tid >> 6, fr = lane & 15, fq = lane >> 4;
    int row0, nvalid;
    if (ch < 128) { row0 = ch * 128; nvalid = 128; } else { row0 = NPR + (ch - 128) * 16; nvalid = 16; }
    {
        const int r = tid >> 1, hf = tid & 1;
        float ss = 0.f;
        if (r < nvalid) {
            const u32x4* src = (const u32x4*)(p->AVp + (size_t)(row0 + r) * 512 + hf * 256);
            for (int i = 0; i < 32; ++i) {
                const u32x4 v = src[i];
#pragma unroll
                for (int c = 0; c < 4; ++c) { const float a = bf_lo(v[c]), b = bf_hi(v[c]); ss += a * a + b * b; }
            }
        }
        ss += __shfl_xor(ss, 1);
        if (hf == 0) rs[r] = (r < nvalid) ? rsqrtf(ss * (1.0f / 512.0f) + EPS) : 0.f;
    }
    __syncthreads();
    {
        const int j = tid >> 1, dh = (tid & 1) * 64;
        const float rj = rs[j];
        for (int c8 = 0; c8 < 8; ++c8) {
            const int d0 = dh + c8 * 8;
            float v[8];
            if (j < nvalid) {
                const u32x4 raw = *(const u32x4*)(p->AVp + (size_t)(row0 + j) * 512 + g * 128 + d0);
                const f32x4 g0 = *(const f32x4*)(p->a_vnorm + l * 512 + g * 128 + d0), g1 = *(const f32x4*)(p->a_vnorm + l * 512 + g * 128 + d0 + 4);
                v[0] = bf_lo(raw.x) * rj * g0[0]; v[1] = bf_hi(raw.x) * rj * g0[1]; v[2] = bf_lo(raw.y) * rj * g0[2]; v[3] = bf_hi(raw.y) * rj * g0[3];
                v[4] = bf_lo(raw.z) * rj * g1[0]; v[5] = bf_hi(raw.z) * rj * g1[1]; v[6] = bf_lo(raw.w) * rj * g1[2]; v[7] = bf_hi(raw.w) * rj * g1[3];
                if (ch >= 128) {
                    float* o = p->out + O_AVS + (size_t)(l * NSM + (ch - 128) * 16 + j) * 512 + g * 128 + d0;
                    *(f32x4*)o = (f32x4){v[0], v[1], v[2], v[3]};
                    *(f32x4*)(o + 4) = (f32x4){v[4], v[5], v[6], v[7]};
                }
            } else {
#pragma unroll
                for (int e = 0; e < 8; ++e) v[e] = 0.f;
            }
#pragma unroll
            for (int e = 0; e < 8; e += 2) {
                const unsigned pk = pk_bf16(v[e], v[e + 1]);
                Vt[(d0 + e) * 136 + j] = (bf16_t)(pk & 0xffffu);
                Vt[(d0 + e + 1) * 136 + j] = (bf16_t)(pk >> 16);
            }
        }
    }
    __syncthreads();
    f32x4 acc[2][8];
#pragma unroll
    for (int mi = 0; mi < 2; ++mi)
#pragma unroll
        for (int dn = 0; dn < 8; ++dn) acc[mi][dn] = (f32x4){0.f, 0.f, 0.f, 0.f};
    const bf16_t* Wg = p->WS + (size_t)(l * 4 + g) * 128 * 128;
#pragma unroll
    for (int kk = 0; kk < 4; ++kk) {
        bf16x8 wf[2];
#pragma unroll
        for (int mi = 0; mi < 2; ++mi) wf[mi] = *(const bf16x8*)(Wg + (w * 32 + mi * 16 + fr) * 128 + kk * 32 + fq * 8);
#pragma unroll
        for (int dn = 0; dn < 8; ++dn) {
            const bf16x8 vf = *(const bf16x8*)(Vt + (dn * 16 + fr) * 136 + kk * 32 + fq * 8);
#pragma unroll
            for (int mi = 0; mi < 2; ++mi) acc[mi][dn] = mfma16(vf, wf[mi], acc[mi][dn]);
        }
    }
#pragma unroll
    for (int mi = 0; mi < 2; ++mi) {
        const int i = w * 32 + mi * 16 + fr;
        if (i < nvalid) {
            const int row = row0 + i;
            const float bias = p->a_bias[(l * 4 + g) * 128 + i];
#pragma unroll
            for (int dn = 0; dn < 8; ++dn) {
                const int d = dn * 16 + fq * 4;
                const u32x2 uu = *(const u32x2*)(p->AU + (size_t)row * 512 + g * 128 + d);
                f32x4 o;
                o[0] = bf_lo(uu.x) * (acc[mi][dn][0] + bias); o[1] = bf_hi(uu.x) * (acc[mi][dn][1] + bias);
                o[2] = bf_lo(uu.y) * (acc[mi][dn][2] + bias); o[3] = bf_hi(uu.y) * (acc[mi][dn][3] + bias);
                st_bf4(p->OA + (size_t)row * 512 + g * 128 + d, o);
            }
        }
    }
    __syncthreads();
}

template <bool SAMPLE> DEVI bf16x8 load_ik(CP p, int l, int b, int kpos, int off) {
    if (!SAMPLE) return *(const bf16x8*)(p->IK + (size_t)(b * SEQ + kpos) * 32 + off);
    const float* src;
    if (kpos < PAST) src = p->cache_b_kidx + ((size_t)(l * 16 + b) * PAST + kpos) * 32 + off;
    else if (kpos < PAST + 16) src = p->out + O_IKS + (size_t)(l * NSM + b * 16 + kpos - PAST) * 32 + off;
    else return zero8();
    return pack8(*(const f32x4*)src, *(const f32x4*)(src + 4));
}
template <bool SAMPLE> DEVI const float* kv_f32_ptr(CP p, const float* cache, int offS, int l, int b, int kidx, int kh, int off) {
    if (kidx < PAST) return cache + (((size_t)(l * 16 + b) * PAST + kidx) * 2 + kh) * 64 + off;
    return p->out + offS + ((size_t)(l * NSM + b * 16 + kidx - PAST) * 2 + kh) * 64 + off;
}

template <int NS> DEVI int select_topk(const unsigned* ukl, int* idxl, int lane, int nkeys) {
    unsigned k[NS];
#pragma unroll
    for (int i = 0; i < NS; ++i) k[i] = ukl[i * 64 + lane];
    unsigned T = 0u;
    int tie_cut = 0x7fffffff;
    bool take_eq = false;
    if (nkeys > 256) {
        for (int bit = 31; bit >= 0; --bit) {
            const unsigned cand = T | (1u << bit);
            int cnt = 0;
#pragma unroll
            for (int i = 0; i < NS; ++i) cnt += __popcll(__ballot(k[i] >= cand));
            if (cnt >= 256) T = cand;
            if (cnt == 256) break;
        }
        int cgt = 0, ceq = 0;
#pragma unroll
        for (int i = 0; i < NS; ++i) { cgt += __popcll(__ballot(k[i] > T)); ceq += __popcll(__ballot(k[i] == T)); }
        const int need = 256 - cgt;
        take_eq = need > 0;
        if (need > 0 && need < ceq) {
            int cur = -1;
            for (int it = 0; it < need; ++it) {
                int mn = 0x7fffffff;
#pragma unroll
                for (int i = 0; i < NS; ++i) { const int id = i * 64 + lane; if (k[i] == T && id > cur && id < mn) mn = id; }
                cur = wave_min_i(mn);
            }
            tie_cut = cur;
        }
    }
    int cl = 0;
#pragma unroll
    for (int i = 0; i < NS; ++i) {
        const bool sel = (k[i] > T) || (take_eq && k[i] == T && (i * 64 + lane) <= tie_cut);
        cl += sel ? 1 : 0;
    }
    int pre = cl;
#pragma unroll
    for (int o = 1; o < 64; o <<= 1) { const int t = __shfl_up(pre, o); if (lane >= o) pre += t; }
    const int base = __builtin_amdgcn_readfirstlane(__shfl(pre, 63));
    int pos = pre - cl;
#pragma unroll
    for (int i = 0; i < NS; ++i) {
        const bool sel = (k[i] > T) || (take_eq && k[i] == T && (i * 64 + lane) <= tie_cut);
        if (sel) { if (pos < 256) idxl[pos] = i * 64 + lane; ++pos; }
    }
    return base;
}

template <bool SAMPLE> DEVI void dsa_query(CP p, int l, int qrow, unsigned* ukl, int* idxl) {
    float* wl = (float*)ukl;
    qrow = __builtin_amdgcn_readfirstlane(qrow);
    const int lane = tid_() & 63, fr = lane & 15, fq = lane >> 4;
    int b, nmain, nsl, nkeys;
    if (!SAMPLE) { b = qrow >> 12; const int t = qrow & 4095; nmain = (t >> 6) + 1; nsl = nmain; nkeys = nmain * 64; }
    else { b = (qrow - NPR) >> 4; nmain = 64; nsl = 65; nkeys = PAST + 16; }
    const bf16x8 qa = *(const bf16x8*)(p->IQ + (size_t)qrow * 256 + (fr & 7) * 32 + fq * 8);
    const f32x4 w4 = *(const f32x4*)(p->IW + (size_t)qrow * 8 + (fq & 1) * 4) * 0.17677669529663687f;
    constexpr int SPI = SAMPLE ? 1 : 2;
    constexpr int GPI = SPI * 4;
    const int niter = (nmain + SPI - 1) / SPI;
    const bf16_t* kpb = p->IK + (size_t)(b * SEQ + fr) * 32 + fq * 8;
    const float* kpf = p->cache_b_kidx + ((size_t)(l * 16 + b) * PAST + fr) * 32 + fq * 8;
    bf16x8 cur[GPI], nxt[GPI];
#pragma unroll
    for (int g = 0; g < GPI; ++g) {
        if (!SAMPLE) cur[g] = *(const bf16x8*)(kpb + g * 512);
        else cur[g] = pack8(*(const f32x4*)(kpf + g * 512), *(const f32x4*)(kpf + g * 512 + 4));
    }
    for (int it = 0; it < niter; ++it) {
        kpb += GPI * 512; kpf += GPI * 512;
        if (it + 1 < niter) {
#pragma unroll
            for (int g = 0; g < GPI; ++g) {
                if (!SAMPLE) nxt[g] = *(const bf16x8*)(kpb + g * 512);
                else nxt[g] = pack8(*(const f32x4*)(kpf + g * 512), *(const f32x4*)(kpf + g * 512 + 4));
            }
        }
        float sg[GPI], tg[GPI];
#pragma unroll
        for (int g = 0; g < GPI; ++g) {
            const f32x4 d = mfma16(qa, cur[g], (f32x4){0.f, 0.f, 0.f, 0.f});
            float s_ = __builtin_amdgcn_fmed3f(d[0], 0.f, 3.0e38f) * w4[0];
            s_ = fmaf(__builtin_amdgcn_fmed3f(d[1], 0.f, 3.0e38f), w4[1], s_);
            s_ = fmaf(__builtin_amdgcn_fmed3f(d[2], 0.f, 3.0e38f), w4[2], s_);
            s_ = fmaf(__builtin_amdgcn_fmed3f(d[3], 0.f, 3.0e38f), w4[3], s_);
            sg[g] = s_;
        }
#pragma unroll
        for (int g = 0; g < GPI; ++g) tg[g] = __shfl_xor(sg[g], 16);
#pragma unroll
        for (int sl = 0; sl < SPI; ++sl) {
            float sc = 0.f;
#pragma unroll
            for (int g = 0; g < 4; ++g) { const float v = sg[sl * 4 + g] + tg[sl * 4 + g]; if (fq == g) sc = v; }
            sc += 0.0f;
            const unsigned u = __float_as_uint(sc);
            ukl[(it * SPI + sl) * 64 + lane] = (u & 0x80000000u) ? ~u : (u | 0x80000000u);
        }
#pragma unroll
        for (int g = 0; g < GPI; ++g) cur[g] = nxt[g];
    }
    if (SAMPLE) {
        const float* src = p->out + O_IKS + (size_t)(l * NSM + b * 16 + fr) * 32 + fq * 8;
        const bf16x8 kb = pack8(*(const f32x4*)src, *(const f32x4*)(src + 4));
        const f32x4 d = mfma16(qa, kb, (f32x4){0.f, 0.f, 0.f, 0.f});
        float s = __builtin_amdgcn_fmed3f(d[0], 0.f, 3.0e38f) * w4[0];
        s = fmaf(__builtin_amdgcn_fmed3f(d[1], 0.f, 3.0e38f), w4[1], s);
        s = fmaf(__builtin_amdgcn_fmed3f(d[2], 0.f, 3.0e38f), w4[2], s);
        s = fmaf(__builtin_amdgcn_fmed3f(d[3], 0.f, 3.0e38f), w4[3], s);
        s += __shfl_xor(s, 16);
        s += 0.0f;
        const unsigned u = __float_as_uint(s);
        const unsigned key = (u & 0x80000000u) ? ~u : (u | 0x80000000u);
        ukl[64 * 64 + lane] = (fq == 0) ? key : 0u;
    }
    int base;
    if (SAMPLE) base = select_topk<65>(ukl, idxl, lane, nkeys);
    else {
        const int ns16 = (nsl + 15) & ~15;
        for (int i = nsl; i < ns16; ++i) ukl[i * 64 + lane] = 0u;
        if (ns16 == 16) base = select_topk<16>(ukl, idxl, lane, nkeys);
        else if (ns16 == 32) base = select_topk<32>(ukl, idxl, lane, nkeys);
        else if (ns16 == 48) base = select_topk<48>(ukl, idxl, lane, nkeys);
        else base = select_topk<64>(ukl, idxl, lane, nkeys);
    }
    const int nsel = base < 256 ? base : 256;
    const int ngr = (nsel + 15) >> 4;
    wave_sync();
    {
        constexpr int GL = SAMPLE ? 2 : 4;
        bf16x8 qf[2][2];
#pragma unroll
        for (int kh = 0; kh < 2; ++kh)
#pragma unroll
            for (int ks = 0; ks < 2; ++ks) {
                qf[kh][ks] = zero8();
                if (fr < 4) qf[kh][ks] = *(const bf16x8*)(p->BQ + (size_t)qrow * 512 + (kh * 4 + fr) * 64 + ks * 32 + fq * 8);
            }
        for (int gi0 = 0; gi0 < ngr; gi0 += GL) {
            bf16x8 kb[GL][2][2];
#pragma unroll
            for (int j = 0; j < GL; ++j) {
                const int n = (gi0 + j) * 16 + fr;
                const int kidx = (n < nsel) ? idxl[n] : 0;
#pragma unroll
                for (int kh = 0; kh < 2; ++kh)
#pragma unroll
                    for (int ks = 0; ks < 2; ++ks) {
                        if (!SAMPLE) kb[j][kh][ks] = *(const bf16x8*)(p->BK + (size_t)(b * SEQ + kidx) * 128 + kh * 64 + ks * 32 + fq * 8);
                        else { const float* s_ = kv_f32_ptr<SAMPLE>(p, p->cache_b_k, O_BKS, l, b, kidx, kh, ks * 32 + fq * 8); kb[j][kh][ks] = pack8(*(const f32x4*)s_, *(const f32x4*)(s_ + 4)); }
                    }
            }
#pragma unroll
            for (int j = 0; j < GL; ++j) {
                const int n = (gi0 + j) * 16 + fr;
#pragma unroll
                for (int kh = 0; kh < 2; ++kh) {
                    f32x4 d = (f32x4){0.f, 0.f, 0.f, 0.f};
                    d = mfma16(qf[kh][0], kb[j][kh][0], d);
                    d = mfma16(qf[kh][1], kb[j][kh][1], d);
                    if (fq == 0 && gi0 + j < ngr) {
                        f32x4 v = d * 0.125f;
                        if (n >= nsel) v = (f32x4){-INFINITY, -INFINITY, -INFINITY, -INFINITY};
                        *(f32x4*)(wl + (kh * 256 + n) * 4) = v;
                    }
                }
            }
        }
    }
    wave_sync();
#pragma unroll
    for (int kh = 0; kh < 2; ++kh) {
        f32x4 x[4];
        f32x4 mx = (f32x4){-INFINITY, -INFINITY, -INFINITY, -INFINITY};
#pragma unroll
        for (int k = 0; k < 4; ++k) {
            const int n = lane + 64 * k;
            x[k] = (n < ngr * 16) ? *(const f32x4*)(wl + (kh * 256 + n) * 4) : (f32x4){-INFINITY, -INFINITY, -INFINITY, -INFINITY};
#pragma unroll
            for (int c = 0; c < 4; ++c) mx[c] = fmaxf(mx[c], x[k][c]);
        }
#pragma unroll
        for (int c = 0; c < 4; ++c) mx[c] = wave_max(mx[c]);
        f32x4 sm = (f32x4){0.f, 0.f, 0.f, 0.f};
#pragma unroll
        for (int k = 0; k < 4; ++k)
#pragma unroll
            for (int c = 0; c < 4; ++c) { x[k][c] = __expf(x[k][c] - mx[c]); sm[c] += x[k][c]; }
#pragma unroll
        for (int c = 0; c < 4; ++c) sm[c] = 1.0f / wave_sum(sm[c]);
#pragma unroll
        for (int k = 0; k < 4; ++k) {
            const int n = lane + 64 * k;
            if (n < ngr * 16) *(f32x4*)(wl + (kh * 256 + n) * 4) = x[k] * sm;
        }
    }
    wave_sync();
    const int kq = lane >> 3, dc = lane & 7;
#pragma unroll
    for (int kh = 0; kh < 2; ++kh) {
        float o[4][8];
#pragma unroll
        for (int hh = 0; hh < 4; ++hh)
#pragma unroll
            for (int e = 0; e < 8; ++e) o[hh][e] = 0.f;
        constexpr int KB = SAMPLE ? 4 : 8;
        constexpr int RW = SAMPLE ? 2 : 1;
        f32x4 ppC[KB], ppN[KB];
        u32x4 rwC[KB][RW], rwN[KB][RW];
#define PV_LOAD(n0_, PP_, RW_) do { \
        _Pragma("unroll") for (int j = 0; j < KB; ++j) { \
            const int n = (n0_) + 8 * j; \
            const bool ok = n < nsel; \
            const int kidx = ok ? idxl[n] : 0; \
            PP_[j] = ok ? *(const f32x4*)(wl + (kh * 256 + n) * 4) : (f32x4){0.f, 0.f, 0.f, 0.f}; \
            if (!SAMPLE) RW_[j][0] = *(const u32x4*)(p->BV + (size_t)(b * SEQ + kidx) * 128 + kh * 64 + dc * 8); \
            else { const float* s_ = kv_f32_ptr<SAMPLE>(p, p->cache_b_v, O_BVS, l, b, kidx, kh, dc * 8); \
                   RW_[j][0] = *(const u32x4*)s_; RW_[j][RW - 1] = *(const u32x4*)(s_ + 4); } \
        } } while (0)
        PV_LOAD(kq, ppC, rwC);
        for (int n0 = kq; n0 < nsel; n0 += 8 * KB) {
            if (n0 + 8 * KB < nsel) PV_LOAD(n0 + 8 * KB, ppN, rwN);
#pragma unroll
            for (int j = 0; j < KB; ++j) {
                float v[8];
                if (!SAMPLE) {
                    v[0] = bf_lo(rwC[j][0].x); v[1] = bf_hi(rwC[j][0].x); v[2] = bf_lo(rwC[j][0].y); v[3] = bf_hi(rwC[j][0].y);
                    v[4] = bf_lo(rwC[j][0].z); v[5] = bf_hi(rwC[j][0].z); v[6] = bf_lo(rwC[j][0].w); v[7] = bf_hi(rwC[j][0].w);
                } else {
                    v[0] = __uint_as_float(rwC[j][0].x); v[1] = __uint_as_float(rwC[j][0].y); v[2] = __uint_as_float(rwC[j][0].z); v[3] = __uint_as_float(rwC[j][0].w);
                    v[4] = __uint_as_float(rwC[j][RW - 1].x); v[5] = __uint_as_float(rwC[j][RW - 1].y); v[6] = __uint_as_float(rwC[j][RW - 1].z); v[7] = __uint_as_float(rwC[j][RW - 1].w);
                }
#pragma unroll
                for (int hh = 0; hh < 4; ++hh)
#pragma unroll
                    for (int e = 0; e < 8; ++e) o[hh][e] = fmaf(ppC[j][hh], v[e], o[hh][e]);
            }
#pragma unroll
            for (int j = 0; j < KB; ++j) { ppC[j] = ppN[j];
#pragma unroll
                for (int q = 0; q < RW; ++q) rwC[j][q] = rwN[j][q]; }
        }
#undef PV_LOAD
#pragma unroll
        for (int hh = 0; hh < 4; ++hh)
#pragma unroll
            for (int e = 0; e < 8; ++e) {
                float t = o[hh][e];
                t += __shfl_xor(t, 8); t += __shfl_xor(t, 16); t += __shfl_xor(t, 32);
                o[hh][e] = t;
            }
        if (kq == 0) {
#pragma unroll
            for (int hh = 0; hh < 4; ++hh) {
                u32x4 w;
                w.x = pk_bf16(o[hh][0], o[hh][1]); w.y = pk_bf16(o[hh][2], o[hh][3]); w.z = pk_bf16(o[hh][4], o[hh][5]); w.w = pk_bf16(o[hh][6], o[hh][7]);
                *(u32x4*)(p->OB + (size_t)qrow * 512 + (kh * 4 + hh) * 64 + dc * 8) = w;
            }
        }
    }
    wave_sync();
}

template <bool SAMPLE> DEVI void stick_unit(CP p, int l, int b, int h, int qt, unsigned char* smem) {
    bf16_t* Ks = (bf16_t*)smem;
    bf16_t* Vt = Ks + 64 * 72;
    bf16_t* Wl = Vt + 64 * 72;
    int* flags = (int*)(Wl + 4 * 16 * 72);
    const int tid = tid_(), lane = tid & 63, w = tid >> 6, fr = lane & 15, fq = lane >> 4;
    bf16_t* Ww = Wl + w * 16 * 72;
    int qrow_a, tbase, k0;
    if (!SAMPLE) { qrow_a = b * SEQ + qt * 64 + w * 16; tbase = qt * 64 + w * 16; k0 = qt * 64; }
    else { qrow_a = NPR + b * 16; tbase = PAST; k0 = PAST; }
    bf16x8 qf[2];
#pragma unroll
    for (int ks = 0; ks < 2; ++ks) qf[ks] = *(const bf16x8*)(p->CQ + (size_t)(qrow_a + fr) * 512 + h * 64 + ks * 32 + fq * 8);
    float R[4] = {0.f, 0.f, 0.f, 0.f};
    f32x4 O[4];
#pragma unroll
    for (int dt = 0; dt < 4; ++dt) O[dt] = (f32x4){0.f, 0.f, 0.f, 0.f};
    for (; k0 >= 0; k0 -= 64) {
        {
            const int key = tid >> 2, part = (tid & 3) * 16;
            u32x4 kr0, kr1, vr0, vr1;
            if (!SAMPLE) {
                const bf16_t* ks_ = p->CK + (size_t)(b * SEQ + k0 + key) * 512 + h * 64 + part;
                const bf16_t* vs_ = p->CV + (size_t)(b * SEQ + k0 + key) * 512 + h * 64 + part;
                kr0 = *(const u32x4*)ks_; kr1 = *(const u32x4*)(ks_ + 8);
                vr0 = *(const u32x4*)vs_; vr1 = *(const u32x4*)(vs_ + 8);
            } else {
                const int pos = k0 + key;
                const float *kp = nullptr, *vp = nullptr;
                if (pos < PAST) {
                    const size_t o = (((size_t)(l * 16 + b) * PAST + pos) * 8 + h) * 64 + part;
                    kp = p->cache_c_k + o; vp = p->cache_c_v + o;
                } else if (pos < PAST + 16) {
                    const size_t o = ((size_t)(l * NSM + b * 16 + pos - PAST) * 8 + h) * 64 + part;
                    kp = p->out + O_CKS + o; vp = p->out + O_CVS + o;
                }
                if (kp) {
                    const f32x4 a0 = *(const f32x4*)kp, a1 = *(const f32x4*)(kp + 4), a2 = *(const f32x4*)(kp + 8), a3 = *(const f32x4*)(kp + 12);
                    const f32x4 c0 = *(const f32x4*)vp, c1 = *(const f32x4*)(vp + 4), c2 = *(const f32x4*)(vp + 8), c3 = *(const f32x4*)(vp + 12);
                    kr0 = __builtin_bit_cast(u32x4, pack8(a0, a1)); kr1 = __builtin_bit_cast(u32x4, pack8(a2, a3));
                    vr0 = __builtin_bit_cast(u32x4, pack8(c0, c1)); vr1 = __builtin_bit_cast(u32x4, pack8(c2, c3));
                } else {
                    kr0 = kr1 = vr0 = vr1 = (u32x4){0u, 0u, 0u, 0u};
                }
            }
            *(u32x4*)(Ks + key * 72 + part) = kr0;
            *(u32x4*)(Ks + key * 72 + part + 8) = kr1;
#pragma unroll
            for (int c = 0; c < 4; ++c) {
                Vt[(part + 2 * c) * 72 + key] = (bf16_t)(vr0[c] & 0xffffu);
                Vt[(part + 2 * c + 1) * 72 + key] = (bf16_t)(vr0[c] >> 16);
                Vt[(part + 8 + 2 * c) * 72 + key] = (bf16_t)(vr1[c] & 0xffffu);
                Vt[(part + 8 + 2 * c + 1) * 72 + key] = (bf16_t)(vr1[c] >> 16);
            }
        }
        __syncthreads();
        float wv[4][4];
        float tot[4][4];
        float cs[4][4];
        float zz[4][4];
#pragma unroll
        for (int n = 0; n < 4; ++n) {
            f32x4 s = (f32x4){0.f, 0.f, 0.f, 0.f};
#pragma unroll
            for (int ks = 0; ks < 2; ++ks) {
                const bf16x8 kf = *(const bf16x8*)(Ks + (n * 16 + fr) * 72 + ks * 32 + fq * 8);
                s = mfma16(qf[ks], kf, s);
            }
            const int kpos = k0 + n * 16 + fr;
#pragma unroll
            for (int j = 0; j < 4; ++j) {
                const float z = s[j] * 0.125f;
                const bool mk = kpos < (tbase + fq * 4 + j);
                const float sp = fmaxf(z, 0.f) + __logf(1.0f + __expf(-fabsf(z)));
                float c = mk ? -sp : 0.f;
                zz[n][j] = z;
#pragma unroll
                for (int d = 1; d < 16; d <<= 1) { const float t = __shfl_down(c, d, 16); if (fr + d < 16) c += t; }
                cs[n][j] = c;
                tot[n][j] = __shfl(c, lane & 48);
            }
        }
#pragma unroll
        for (int j = 0; j < 4; ++j) {
            float add = R[j];
#pragma unroll
            for (int n = 3; n >= 0; --n) {
                const int kpos = k0 + n * 16 + fr;
                const bool mk = kpos < (tbase + fq * 4 + j);
                const float e = zz[n][j] + cs[n][j] + add;
                wv[n][j] = mk ? __expf(e) : 0.f;
                add += tot[n][j];
            }
            R[j] = add;
        }
#pragma unroll
        for (int n = 0; n < 4; ++n)
#pragma unroll
            for (int j = 0; j < 4; j += 2) {
                const unsigned pk = pk_bf16(wv[n][j], wv[n][j + 1]);
                Ww[(fq * 4 + j) * 72 + n * 16 + fr] = (bf16_t)(pk & 0xffffu);
                Ww[(fq * 4 + j + 1) * 72 + n * 16 + fr] = (bf16_t)(pk >> 16);
            }
        const bool mine = (R[0] < -30.f) && (R[1] < -30.f) && (R[2] < -30.f) && (R[3] < -30.f);
        const int alldone = __all(mine);
        if (lane == 0) flags[w] = alldone;
        __syncthreads();
#pragma unroll
        for (int ks = 0; ks < 2; ++ks) {
            const bf16x8 wf = *(const bf16x8*)(Ww + fr * 72 + ks * 32 + fq * 8);
#pragma unroll
            for (int dt = 0; dt < 4; ++dt) {
                const bf16x8 vf = *(const bf16x8*)(Vt + (dt * 16 + fr) * 72 + ks * 32 + fq * 8);
                O[dt] = mfma16(wf, vf, O[dt]);
            }
        }
        const int done = flags[0] & flags[1] & flags[2] & flags[3];
        __syncthreads();
        if (done) break;
    }
    if (!SAMPLE || w == 0) {
#pragma unroll
        for (int dt = 0; dt < 4; ++dt)
#pragma unroll
            for (int j = 0; j < 4; j += 2) {
                const unsigned pk = pk_bf16(O[dt][j], O[dt][j + 1]);
                p->OC[(size_t)(qrow_a + fq * 4 + j) * 512 + h * 64 + dt * 16 + fr] = (bf16_t)(pk & 0xffffu);
                p->OC[(size_t)(qrow_a + fq * 4 + j + 1) * 512 + h * 64 + dt * 16 + fr] = (bf16_t)(pk >> 16);
            }
    }
}

constexpr int NI_BS = NSM / 4, NI_BP = NPR / 4, NI_C = 2048 + 128, NI_A = 144 * 4;
constexpr int NI_TOTAL = NI_BS + NI_BP + NI_C + NI_A;
DEVI void phase_mixers(CP p, int l, unsigned char* smem, unsigned char* smem1, int* s_item) {
    const int tid = tid_();
    const int w = __builtin_amdgcn_readfirstlane(tid >> 6);
    unsigned char* wb = (w < 2) ? smem + w * 17664 : smem1 + (w - 2) * 17664;
    unsigned* wl = (unsigned*)wb;
    int* idxl = (int*)(wb + 16640);
    unsigned* ctr = p->bar + XCD_BAR_WORDS + 64 * l;
    if (tid == 0) *s_item = (int)__hip_atomic_fetch_add(ctr, 1u, __ATOMIC_RELAXED, __HIP_MEMORY_SCOPE_AGENT);
    __syncthreads();
    int item = __builtin_amdgcn_readfirstlane(*s_item);
    while (item < NI_TOTAL) {
        int nxt = 0;
        if (tid == 0) nxt = (int)__hip_atomic_fetch_add(ctr, 1u, __ATOMIC_RELAXED, __HIP_MEMORY_SCOPE_AGENT);
        if (item < NI_BS) {
            dsa_query<true>(p, l, NPR + item * 4 + w, wl, idxl);
        } else if (item < NI_BS + NI_BP) {
            const int k = item - NI_BS;
            const int bb = k >> 10, tt = 1023 - (k & 1023);
            dsa_query<false>(p, l, bb * SEQ + tt * 4 + w, wl, idxl);
        } else if (item < NI_BS + NI_BP + NI_C) {
            __syncthreads();
            const int u = item - NI_BS - NI_BP;
            if (u < 2048) { const int h = u & 7, qt = 63 - ((u >> 3) & 63), bb = u >> 9; stick_unit<false>(p, l, bb, h, qt, smem); }
            else { const int v = u - 2048; stick_unit<true>(p, l, v >> 3, v & 7, 0, smem); }
        } else {
            __syncthreads();
            const int u = item - NI_BS - NI_BP - NI_C;
            amix_unit(p, l, u >> 2, u & 3, smem);
        }
        __syncthreads();
        if (tid == 0) *s_item = nxt;
        __syncthreads();
        item = __builtin_amdgcn_readfirstlane(*s_item);
    }
}

template <int NT>
DEVI void phase_merge(CP p, int l, unsigned char* smem, unsigned char* smem1, int rt0, int nrt) {
    const int tid = tid_(), lane = tid & 63, wid = tid >> 6, wr = wid >> 1, wc = wid & 1, fr = lane & 15, fq = lane >> 4;
    constexpr int NCT = DM / (NT * 32);
    TileMap tm; tm.init(nrt, NCT);
    for (int v = tm.j; v < tm.total; v += tm.J) {
        int ct, rt; tm.get(v, rt, ct); rt += rt0;
        f32x4 mg[4][NT];
        zero_acc<NT>(mg);
        const int rbase = rt * 128 + wr * 64 + fr, cb = ct * (NT * 32) + wc * (NT * 16) + fq * 4;
#pragma unroll 1
        for (int br = 0; br < 3; ++br) {
            const bf16_t* A = (br == 0) ? p->OA : (br == 1) ? p->OB : p->OC;
            const bf16_t* W = ((br == 0) ? p->Wa : (br == 1) ? p->Wb : p->Wc) + (size_t)l * DM * 512;
            f32x4 acc[4][NT];
            zero_acc<NT>(acc);
            gemm_acc<NT>(acc, A + (size_t)rt * 128 * 512, 512, W + (size_t)ct * (NT * 32) * 512, 512, 512, smem, smem1);
#pragma unroll
            for (int m = 0; m < 4; ++m)
#pragma unroll
                for (int n = 0; n < NT; ++n) {
                    const u32x2 gg = *(const u32x2*)(p->G + (size_t)(rbase + m * 16) * 3072 + br * 1024 + cb + n * 16);
                    mg[m][n][0] += bf_lo(gg.x) * acc[m][n][0]; mg[m][n][1] += bf_hi(gg.x) * acc[m][n][1];
                    mg[m][n][2] += bf_lo(gg.y) * acc[m][n][2]; mg[m][n][3] += bf_hi(gg.y) * acc[m][n][3];
                }
        }
#pragma unroll
        for (int m = 0; m < 4; ++m)
#pragma unroll
            for (int n = 0; n < NT; ++n) st_bf4(p->MG + (size_t)(rbase + m * 16) * DM + cb + n * 16, mg[m][n]);
    }
}

template <int NT>
DEVI void phase_resid(CP p, const bf16_t* A, int K, const bf16_t* W, bool from_inputs, unsigned char* smem, unsigned char* smem1, int rt0, int nrt) {
    const int tid = tid_(), lane = tid & 63, wid = tid >> 6, wr = wid >> 1, wc = wid & 1, fr = lane & 15, fq = lane >> 4;
    constexpr int NCT = DM / (NT * 32);
    TileMap tm; tm.init(nrt, NCT);
    for (int v = tm.j; v < tm.total; v += tm.J) {
        int ct, rt; tm.get(v, rt, ct); rt += rt0;
        f32x4 acc[4][NT];
        zero_acc<NT>(acc);
        gemm_acc<NT>(acc, A + (size_t)rt * 128 * K, K, W + (size_t)ct * (NT * 32) * K, K, K, smem, smem1);
        const int rbase = rt * 128 + wr * 64 + fr, cb = ct * (NT * 32) + wc * (NT * 16) + fq * 4;
#pragma unroll
        for (int m = 0; m < 4; ++m)
#pragma unroll
            for (int n = 0; n < NT; ++n) {
                const int row = rbase + m * 16;
                float* xp = p->X + (size_t)row * DM + cb + n * 16;
                const float* bp = !from_inputs ? xp : (row < NPR ? p->x_prompt + (size_t)row * DM : p->x_sample + (size_t)(row - NPR) * DM) + cb + n * 16;
                *(f32x4*)xp = *(const f32x4*)bp + acc[m][n];
            }
    }
}

DEVI void phase_ffn_in(CP p, int l, unsigned char* smem, unsigned char* smem1) {
    const int tid = tid_(), lane = tid & 63, wid = tid >> 6, wr = wid >> 1, wc = wid & 1, fr = lane & 15, fq = lane >> 4;
    constexpr int NCT = NFFI / 128, NRT = MT / 128;
    TileMap tm; tm.init(NRT, NCT);
    for (int v = tm.j; v < tm.total; v += tm.J) {
        int ct, rt; tm.get(v, rt, ct);
        f32x4 acc[4][4];
        zero_acc<4>(acc);
        gemm_acc<4>(acc, p->H + (size_t)rt * 128 * DM, DM, p->Wffi + ((size_t)l * NFFI + ct * 128) * DM, DM, DM, smem, smem1);
        const int rbase = rt * 128 + wr * 64 + fr, cb = ct * 64 + wc * 32 + fq * 4;
#pragma unroll
        for (int m = 0; m < 4; ++m)
#pragma unroll
            for (int n = 0; n < 2; ++n) {
                const f32x4 g = acc[m][n], up = acc[m][n + 2];
                f32x4 o;
#pragma unroll
                for (int j = 0; j < 4; ++j) o[j] = g[j] * sigmoidf_(g[j]) * up[j];
                st_bf4(p->ACT + (size_t)(rbase + m * 16) * DFF + cb + n * 16, o);
            }
    }
}

template <int NT>
DEVI void phase_ple(CP p, int l, unsigned char* smem, unsigned char* smem1, int rt0, int nrt) {
    const int tid = tid_(), lane = tid & 63, wid = tid >> 6, wr = wid >> 1, wc = wid & 1, fr = lane & 15, fq = lane >> 4;
    constexpr int NCT = DM / (NT * 32);
    TileMap tm; tm.init(nrt, NCT);
    for (int v = tm.j; v < tm.total; v += tm.J) {
        int ct, rt; tm.get(v, rt, ct); rt += rt0;
        f32x4 sg[4][NT];
        zero_acc<NT>(sg);
        gemm_acc<NT>(sg, p->H + (size_t)rt * 128 * DM, DM, p->Wpg + ((size_t)l * DM + ct * (NT * 32)) * DM, DM, DM, smem, smem1);
#pragma unroll
        for (int m = 0; m < 4; ++m)
#pragma unroll
            for (int n = 0; n < NT; ++n)
#pragma unroll
                for (int j = 0; j < 4; ++j) sg[m][n][j] = sigmoidf_(sg[m][n][j]);
        f32x4 acc[4][NT];
        zero_acc<NT>(acc);
        gemm_acc<NT>(acc, p->P + ((size_t)l * MT + rt * 128) * 256, 256, p->Wpp + ((size_t)l * DM + ct * (NT * 32)) * 256, 256, 256, smem, smem1);
        const int rbase = rt * 128 + wr * 64 + fr, cb = ct * (NT * 32) + wc * (NT * 16) + fq * 4;
#pragma unroll
        for (int m = 0; m < 4; ++m)
#pragma unroll
            for (int n = 0; n < NT; ++n) {
                const int row = rbase + m * 16;
                float* xp = p->X + (size_t)row * DM + cb + n * 16;
                const f32x4 r = *(const f32x4*)xp + sg[m][n] * acc[m][n];
                *(f32x4*)xp = r;
                if (l == 1) __builtin_nontemporal_store(r, (f32x4*)(p->out + (size_t)row * DM + cb + n * 16));
            }
    }
}

#define XB_TMO      128
#define XB_XCNT(j)  (256  + 64 * (j))
#define XB_XSUB(j)  (1280 + 64 * (j))
#define XB_XGEN(j)  (2304 + 64 * (j))
#define XB_TOP      3328
#define XB_TOPGEN   3392
#define XB_SPIN_CAP (1u << 18)
#define LAS __attribute__((address_space(3)))
DEVI unsigned xb_ld(unsigned* p) { return __hip_atomic_load(p, __ATOMIC_RELAXED, __HIP_MEMORY_SCOPE_AGENT); }
DEVI unsigned xb_add(unsigned* p, unsigned v) { return __hip_atomic_fetch_add(p, v, __ATOMIC_RELAXED, __HIP_MEMORY_SCOPE_AGENT); }
DEVI unsigned xb_xcc_id() { return (unsigned)__builtin_amdgcn_s_getreg((3 << 11) | 20) & 0xFu; }
#define XB_SPIN(cond, bar) do { unsigned _sp = 0; while (cond) { __builtin_amdgcn_s_sleep(1); \
    if ((++_sp & 255u) == 0u) { if (xb_ld(&(bar)[XB_TMO])) break; if (_sp > XB_SPIN_CAP) { atomicAdd(&(bar)[XB_TMO], 1u); break; } } } } while (0)
struct XcdBarrier { unsigned* bar; unsigned x; volatile LAS unsigned* st; };
DEVI XcdBarrier xcd_barrier_post(unsigned* bar, volatile LAS unsigned* st) {
    XcdBarrier b; b.bar = bar; b.x = xb_xcc_id(); b.st = st;
    if (__builtin_amdgcn_workitem_id_x() == 0) (void)xb_add(&bar[XB_XCNT(b.x)], 1u);
    return b;
}
DEVI void xcd_barrier_complete(unsigned* bar, unsigned x, unsigned& nloc, unsigned& nx) {
    const unsigned G = gridDim.x * gridDim.y * gridDim.z;
    unsigned sum, cnt, mine, sp = 0u;
    for (;;) {
        sum = 0u; cnt = 0u; mine = 0u;
#pragma unroll
        for (unsigned j = 0; j < 16; ++j) { const unsigned c = xb_ld(&bar[XB_XCNT(j)]); sum += c; cnt += (c > 0u) ? 1u : 0u; mine = (j == x) ? c : mine; }
        if (sum == G) break;
        __builtin_amdgcn_s_sleep(1);
        if ((++sp & 255u) == 0u) { if (xb_ld(&bar[XB_TMO])) break; if (sp > XB_SPIN_CAP) { atomicAdd(&bar[XB_TMO], 1u); break; } }
    }
    nloc = mine > 0u ? mine : 1u; nx = cnt > 0u ? cnt : 1u;
}
DEVI void xcd_barrier(const XcdBarrier& b) {
    asm volatile("s_waitcnt vmcnt(0)" ::: "memory");
    __syncthreads();
    if (__builtin_amdgcn_workitem_id_x() == 0) {
        unsigned* bar = b.bar;
        __builtin_amdgcn_s_waitcnt(0);
        unsigned nloc = b.st[0], nx = b.st[1];
        if (nloc == 0u) { xcd_barrier_complete(bar, b.x, nloc, nx); b.st[0] = nloc; b.st[1] = nx; }
        const unsigned old = xb_add(&bar[XB_XSUB(b.x)], 1u);
        const unsigned gen = old / nloc;
        if (old + 1u == (gen + 1u) * nloc) {
            __builtin_amdgcn_fence(__ATOMIC_RELEASE, "agent");
            asm volatile("s_waitcnt vmcnt(0)" ::: "memory");
            const unsigned og = xb_add(&bar[XB_TOP], 1u);
            const unsigned tg = og / nx;
            if (og + 1u == (tg + 1u) * nx) xb_add(&bar[XB_TOPGEN], 1u);
            else XB_SPIN(xb_ld(&bar[XB_TOPGEN]) == tg, bar);
            __builtin_amdgcn_fence(__ATOMIC_ACQUIRE, "agent");
            xb_add(&bar[XB_XGEN(b.x)], 1u);
            asm volatile("s_waitcnt vmcnt(0)" ::: "memory");
        } else {
            XB_SPIN(xb_ld(&bar[XB_XGEN(b.x)]) == gen, bar);
            __builtin_amdgcn_fence(__ATOMIC_ACQUIRE, "agent");
            asm volatile("s_waitcnt vmcnt(0)" ::: "memory");
        }
    }
    __syncthreads();
}

__global__ void __launch_bounds__(256, 2) mega(Params p_by_value) {
    cg::grid_group grid = cg::this_grid();
    __shared__ __attribute__((aligned(16))) unsigned char smem[SMEM_HALF];
    __shared__ __attribute__((aligned(16))) unsigned char smem1[SMEM_HALF];
    __shared__ uint4 xb_words;
    __shared__ int s_item[4];
    if (__builtin_amdgcn_workitem_id_x() == 0) xb_words = make_uint4(0u, 0u, 0u, 0u);
    __syncthreads();
    CP p = (CP)__builtin_amdgcn_kernarg_segment_ptr();
    if (launder(p)->out == nullptr) grid.sync();
    XcdBarrier xb = xcd_barrier_post(launder(p)->bar, (volatile LAS unsigned*)&xb_words);
    phase0(launder(p), smem);
    xcd_barrier(xb);
    for (int l = 0; l < 2; ++l) {
        if (l > 0) { CP q = launder(p); norm_phase(q->X, q->X + (size_t)NPR * DM, q->norm_mix + l * DM, q->H, nullptr); xcd_barrier(xb); }
        phase_gemm_in(launder(p), l, smem, smem1);
        xcd_barrier(xb);
        phase_mixers(launder(p), l, smem, smem1, s_item);
        xcd_barrier(xb);
        phase_merge<4>(launder(p), l, smem, smem1, 0, 128);
        phase_merge<1>(launder(p), l, smem, smem1, 128, 2);
        xcd_barrier(xb);
        { CP q = launder(p); phase_resid<4>(q, q->MG, DM, q->Wout + (size_t)l * DM * DM, l == 0, smem, smem1, 0, 128); }
        { CP q = launder(p); phase_resid<1>(q, q->MG, DM, q->Wout + (size_t)l * DM * DM, l == 0, smem, smem1, 128, 2); }
        xcd_barrier(xb);
        { CP q = launder(p); norm_phase(q->X, q->X + (size_t)NPR * DM, q->norm_ffn + l * DM, q->H, nullptr); }
        xcd_barrier(xb);
        phase_ffn_in(launder(p), l, smem, smem1);
        xcd_barrier(xb);
        { CP q = launder(p); phase_resid<4>(q, q->ACT, DFF, q->Wffo + (size_t)l * DM * DFF, false, smem, smem1, 0, 128); }
        { CP q = launder(p); phase_resid<1>(q, q->ACT, DFF, q->Wffo + (size_t)l * DM * DFF, false, smem, smem1, 128, 2); }
        xcd_barrier(xb);
        { CP q = launder(p); norm_phase(q->X, q->X + (size_t)NPR * DM, q->norm_ple + l * DM, q->H, nullptr); }
        xcd_barrier(xb);
        phase_ple<4>(launder(p), l, smem, smem1, 0, 128);
        phase_ple<1>(launder(p), l, smem, smem1, 128, 2);
        if (l == 0) xcd_barrier(xb);
    }
}

extern "C" void kernel_launch(void* const* d_in, const int* in_sizes, int n_in, void* d_out, int out_size, void* d_ws, size_t ws_size, hipStream_t stream) {
    static int grid_blocks = 0;
    if (!grid_blocks) {
        int dev = 0, cus = 0, per_cu = 0;
        hipGetDevice(&dev);
        hipDeviceGetAttribute(&cus, hipDeviceAttributeMultiprocessorCount, dev);
        hipOccupancyMaxActiveBlocksPerMultiprocessor(&per_cu, mega, 256, 0);
        if (per_cu > 2) per_cu = 2;
        if (per_cu < 1) per_cu = 1;
        grid_blocks = cus * per_cu;
    }
    Params hp{};
    const float** fin = (const float**)&hp;
    for (int i = 0; i < 27; ++i) fin[i] = (const float*)d_in[i];
    hp.out = (float*)d_out;
    unsigned char* ws = (unsigned char*)d_ws;
    size_t off = 0;
    auto take = [&](size_t bytes) { void* r = ws + off; off += (bytes + 255) & ~(size_t)255; return r; };
    hp.Win = (bf16_t*)take((size_t)2 * NIN * DM * 2);
    hp.Wa = (bf16_t*)take((size_t)2 * DM * 512 * 2);
    hp.Wb = (bf16_t*)take((size_t)2 * DM * 512 * 2);
    hp.Wc = (bf16_t*)take((size_t)2 * DM * 512 * 2);
    hp.Wout = (bf16_t*)take((size_t)2 * DM * DM * 2);
    hp.Wffi = (bf16_t*)take((size_t)2 * NFFI * DM * 2);
    hp.Wffo = (bf16_t*)take((size_t)2 * DM * DFF * 2);
    hp.Wpg = (bf16_t*)take((size_t)2 * DM * DM * 2);
    hp.Wpp = (bf16_t*)take((size_t)2 * DM * 256 * 2);
    hp.WS = (bf16_t*)take((size_t)2 * 4 * 128 * 128 * 2);
    hp.X = (float*)take((size_t)MT * DM * 4);
    hp.H = (bf16_t*)take((size_t)MT * DM * 2);
    hp.AU = (bf16_t*)take((size_t)MT * 512 * 2);
    hp.AVp = (bf16_t*)take((size_t)MT * 512 * 2);
    hp.BQ = (bf16_t*)take((size_t)MT * 512 * 2);
    hp.BK = (bf16_t*)take((size_t)MT * 128 * 2);
    hp.BV = (bf16_t*)take((size_t)MT * 128 * 2);
    hp.IQ = (bf16_t*)take((size_t)MT * 256 * 2);
    hp.IK = (bf16_t*)take((size_t)MT * 32 * 2);
    hp.IW = (float*)take((size_t)MT * 8 * 4);
    hp.CQ = (bf16_t*)take((size_t)MT * 512 * 2);
    hp.CK = (bf16_t*)take((size_t)MT * 512 * 2);
    hp.CV = (bf16_t*)take((size_t)MT * 512 * 2);
    hp.G = (bf16_t*)take((size_t)MT * 3072 * 2);
    hp.OA = (bf16_t*)take((size_t)MT * 512 * 2);
    hp.OB = (bf16_t*)take((size_t)MT * 512 * 2);
    hp.OC = (bf16_t*)take((size_t)MT * 512 * 2);
    hp.MG = (bf16_t*)take((size_t)MT * DM * 2);
    hp.ACT = (bf16_t*)take((size_t)MT * DFF * 2);
    hp.P = (bf16_t*)take((size_t)2 * MT * 256 * 2);
    hp.bar = (unsigned*)take((size_t)(XCD_BAR_WORDS + 256) * 4);
    hipMemsetAsync(hp.bar, 0, (size_t)(XCD_BAR_WORDS + 256) * 4, stream);
    void* args[] = {&hp};
    hipError_t e = hipLaunchCooperativeKernel((void*)mega, dim3(grid_blocks), dim3(256), args, 0, stream);
    if (e != hipSuccess) fprintf(stderr, "cooperative launch failed: %s (grid %d)\n", hipGetErrorString(e), grid_blocks);
}
```

```cpp
#include <hip/hip_runtime.h>
#include <hip/hip_cooperative_groups.h>
#include <stdint.h>
#include <cstdio>
namespace cg = cooperative_groups;

typedef unsigned short bf16_t;
typedef short bf16x8 __attribute__((ext_vector_type(8)));
typedef float f32x4 __attribute__((ext_vector_type(4)));
typedef unsigned u32x4 __attribute__((ext_vector_type(4)));
typedef unsigned u32x2 __attribute__((ext_vector_type(2)));
#define DEVI __device__ __forceinline__

constexpr int DM = 1024, NPR = 16384, NSM = 256, MT = NPR + NSM, SEQ = 4096, PAST = 4096;
constexpr int NIN = 6784, INSRC = 6696, DFF = 2816, NFFI = 5632;
constexpr float EPS = 1e-6f;
constexpr int O_YP = 0;
constexpr int O_YS = O_YP + NPR * DM;
constexpr int O_BKP = O_YS + NSM * DM;
constexpr int O_BVP = O_BKP + 2 * NPR * 128;
constexpr int O_IKP = O_BVP + 2 * NPR * 128;
constexpr int O_CKP = O_IKP + 2 * NPR * 32;
constexpr int O_CVP = O_CKP + 2 * NPR * 512;
constexpr int O_BKS = O_CVP + 2 * NPR * 512;
constexpr int O_BVS = O_BKS + 2 * NSM * 128;
constexpr int O_IKS = O_BVS + 2 * NSM * 128;
constexpr int O_CKS = O_IKS + 2 * NSM * 32;
constexpr int O_CVS = O_CKS + 2 * NSM * 512;
constexpr int O_AVS = O_CVS + 2 * NSM * 512;

constexpr int SMEM_HALF = 35328;
#define XCD_BAR_WORDS 3456

struct Params {
    const float *x_prompt, *x_sample, *cache_b_k, *cache_b_v, *cache_b_kidx, *cache_c_k, *cache_c_v, *p_prompt, *p_sample;
    const float *norm_mix, *w_in, *gate_bias, *a_vnorm, *a_ws, *a_bias, *b_qnorm, *b_knorm, *w_br_a, *w_br_b, *w_br_c, *w_out;
    const float *norm_ffn, *w_ffn_in, *w_ffn_out, *norm_ple, *w_ple_gate, *w_ple_proj;
    float* out;
    bf16_t *Win, *Wa, *Wb, *Wc, *Wout, *Wffi, *Wffo, *Wpg, *Wpp, *WS;
    float* X;
    bf16_t *H, *AU, *AVp, *BQ, *BK, *BV, *IQ, *IK;
    float* IW;
    bf16_t *CQ, *CK, *CV, *G, *OA, *OB, *OC, *MG, *ACT, *P;
    unsigned* bar;
};

typedef const __attribute__((address_space(4))) Params* CP;
DEVI CP launder(CP q) { asm volatile("" : "+s"(q)); return q; }

DEVI int tid_() { int t = __builtin_amdgcn_workitem_id_x(); asm volatile("" : "+v"(t)); return t; }
typedef float f32x2_t __attribute__((ext_vector_type(2)));
typedef __bf16 bf16x2_t __attribute__((ext_vector_type(2)));
DEVI unsigned pk_bf16(float lo, float hi) { const f32x2_t v = {lo, hi}; return __builtin_bit_cast(unsigned, __builtin_convertvector(v, bf16x2_t)); }
DEVI float bf_lo(unsigned u) { return __uint_as_float(u << 16); }
DEVI float bf_hi(unsigned u) { return __uint_as_float(u & 0xffff0000u); }
DEVI void st_bf4(bf16_t* dst, f32x4 v) { u32x2 w; w.x = pk_bf16(v[0], v[1]); w.y = pk_bf16(v[2], v[3]); *(u32x2*)dst = w; }
DEVI float sigmoidf_(float x) { return __builtin_amdgcn_rcpf(1.0f + __expf(-x)); }
DEVI float gelu_tanh(float x) { float u = 0.7978845608028654f * (x + 0.044715f * x * x * x); return x * sigmoidf_(2.0f * u); }
DEVI f32x4 mfma16(bf16x8 a, bf16x8 b, f32x4 c) { return __builtin_amdgcn_mfma_f32_16x16x32_bf16(a, b, c, 0, 0, 0); }
DEVI bf16x8 pack8(f32x4 a, f32x4 b) {
    u32x4 w; w.x = pk_bf16(a[0], a[1]); w.y = pk_bf16(a[2], a[3]); w.z = pk_bf16(b[0], b[1]); w.w = pk_bf16(b[2], b[3]);
    return __builtin_bit_cast(bf16x8, w);
}
DEVI bf16x8 zero8() { u32x4 w = {0u, 0u, 0u, 0u}; return __builtin_bit_cast(bf16x8, w); }
DEVI void wave_sync() {
    __builtin_amdgcn_fence(__ATOMIC_RELEASE, "wavefront");
    __builtin_amdgcn_wave_barrier();
    __builtin_amdgcn_fence(__ATOMIC_ACQUIRE, "wavefront");
}
DEVI float wave_sum(float v) {
#pragma unroll
    for (int o = 1; o < 64; o <<= 1) v += __shfl_xor(v, o);
    return v;
}
DEVI float wave_max(float v) {
#pragma unroll
    for (int o = 1; o < 64; o <<= 1) v = fmaxf(v, __shfl_xor(v, o));
    return v;
}
DEVI int wave_sum_i(int v) {
#pragma unroll
    for (int o = 1; o < 64; o <<= 1) v += __shfl_xor(v, o);
    return v;
}
DEVI int wave_min_i(int v) {
#pragma unroll
    for (int o = 1; o < 64; o <<= 1) { const int t = __shfl_xor(v, o); v = t < v ? t : v; }
    return v;
}
DEVI float* state_out(float* out, int offP, int offS, int l, int row, int W) {
    return (row < NPR) ? out + offP + (size_t)(l * NPR + row) * W : out + offS + (size_t)(l * NSM + (row - NPR)) * W;
}

typedef __attribute__((address_space(3))) unsigned char* LdsP;
template <int NT>
DEVI void gemm_acc(f32x4 (&acc)[4][NT], const bf16_t* __restrict__ A, int lda, const bf16_t* __restrict__ Bt, int ldb, int K, unsigned char* smem0, unsigned char* smem1) {
    const int tid = tid_(), lane = tid & 63, wid = __builtin_amdgcn_readfirstlane(tid >> 6), wr = wid >> 1, wc = wid & 1, fr = lane & 15, fq = lane >> 4;
    LdsP lds0 = (LdsP)smem0;
    LdsP lds1 = (LdsP)smem1;
    constexpr int ABYTES = 128 * 128;
    const int csw = (lane & 7) ^ (((wid & 1) << 2) | (lane >> 4));
    const int rl = wid * 8 + (lane >> 3);
    const bf16_t* Ag = A + (size_t)rl * lda + csw * 8;
    const bf16_t* Bg = Bt + (size_t)rl * ldb + csw * 8;
    const int sw = fr >> 1;
    const int aoff = (wr * 64 + fr) * 128;
    const int boff = ABYTES + (wc * (NT * 16) + fr) * 128;
    const int nk = K >> 6;
    __syncthreads();
#define GEMM_ISSUE(kt_, L_) do { \
        _Pragma("unroll") for (int i_ = 0; i_ < 4; ++i_) \
            __builtin_amdgcn_global_load_lds((const unsigned*)(Ag + (size_t)(32 * i_) * lda + (kt_) * 64), (__attribute__((address_space(3))) unsigned*)((L_) + wid * 1024 + i_ * 4096), 16, 0, 0); \
        _Pragma("unroll") for (int i_ = 0; i_ < NT; ++i_) \
            __builtin_amdgcn_global_load_lds((const unsigned*)(Bg + (size_t)(32 * i_) * ldb + (kt_) * 64), (__attribute__((address_space(3))) unsigned*)((L_) + ABYTES + wid * 1024 + i_ * 4096), 16, 0, 0); \
    } while (0)
#define GEMM_COMPUTE(L_) do { \
        _Pragma("unroll") for (int ks = 0; ks < 2; ++ks) { \
            const int co = ((ks * 4 + fq) ^ sw) << 4; \
            bf16x8 af[4], bfr[NT]; \
            _Pragma("unroll") for (int m = 0; m < 4; ++m) af[m] = *(const __attribute__((address_space(3))) bf16x8*)((L_) + aoff + m * 2048 + co); \
            _Pragma("unroll") for (int n = 0; n < NT; ++n) bfr[n] = *(const __attribute__((address_space(3))) bf16x8*)((L_) + boff + n * 2048 + co); \
            __builtin_amdgcn_s_setprio(1); \
            _Pragma("unroll") for (int m = 0; m < 4; ++m) \
                _Pragma("unroll") for (int n = 0; n < NT; ++n) acc[m][n] = mfma16(bfr[n], af[m], acc[m][n]); \
            __builtin_amdgcn_s_setprio(0); \
        } } while (0)
    GEMM_ISSUE(0, lds0);
    for (int kt = 0; kt < nk; kt += 2) {
        asm volatile("s_waitcnt vmcnt(0)" ::: "memory");
        __syncthreads();
        GEMM_ISSUE(kt + 1, lds1);
        GEMM_COMPUTE(lds0);
        asm volatile("s_waitcnt vmcnt(0)" ::: "memory");
        __syncthreads();
        if (kt + 2 < nk) GEMM_ISSUE(kt + 2, lds0);
        GEMM_COMPUTE(lds1);
    }
#undef GEMM_ISSUE
#undef GEMM_COMPUTE
}
template <int NT>
DEVI void zero_acc(f32x4 (&acc)[4][NT]) {
#pragma unroll
    for (int m = 0; m < 4; ++m)
#pragma unroll
        for (int n = 0; n < NT; ++n) acc[m][n] = (f32x4){0.f, 0.f, 0.f, 0.f};
}

struct TileMap {
    int x, j, J, nct, rows, full, remr, total;
    DEVI void init(int nrt, int nct_) {
        const int G = gridDim.x;
        nct = nct_;
        if ((G & 7) == 0) { x = blockIdx.x & 7; j = blockIdx.x >> 3; J = G >> 3; rows = (nrt - x + 7) >> 3; }
        else { x = -1; j = blockIdx.x; J = G; rows = nrt; }
        full = rows >> 3; remr = rows & 7; total = rows * nct;
    }
    DEVI void get(int v, int& rt, int& ct) const {
        int g = v / (8 * nct), ri;
        if (g < full) { const int rem = v - g * 8 * nct; ct = rem >> 3; ri = rem & 7; }
        else { g = full; const int rem = v - full * 8 * nct; ct = rem / remr; ri = rem - ct * remr; }
        const int lr = g * 8 + ri;
        rt = (x >= 0) ? x + 8 * lr : lr;
    }
};

DEVI int map_col(int mode, int n) {
    if (mode == 0) return n;
    if (mode == 1) { if (n < 2088) return n; if (n < 2176) return -1; return n - 88; }
    const int T = n >> 7, wc = (n >> 6) & 1, nn = (n >> 4) & 3, i = n & 15;
    return (nn >> 1) * DFF + T * 64 + wc * 32 + (nn & 1) * 16 + i;
}
DEVI void conv_tile(const float* __restrict__ W, int Nsrc, int K, bf16_t* __restrict__ Bt, int mode, int tn, int tk, float* tile) {
    const int tid = tid_();
    {
        const int kk = tid >> 4, n4 = (tid & 15) * 4;
        const int src = map_col(mode, tn * 64 + n4);
        f32x4 v[8];
#pragma unroll
        for (int ps = 0; ps < 8; ++ps) {
            v[ps] = (f32x4){0.f, 0.f, 0.f, 0.f};
            if (src >= 0) v[ps] = __builtin_nontemporal_load((const f32x4*)(W + (size_t)(tk * 128 + ps * 16 + kk) * Nsrc + src));
        }
#pragma unroll
        for (int ps = 0; ps < 8; ++ps) {
            const int k = ps * 16 + kk;
            tile[k * 65 + n4 + 0] = v[ps][0]; tile[k * 65 + n4 + 1] = v[ps][1]; tile[k * 65 + n4 + 2] = v[ps][2]; tile[k * 65 + n4 + 3] = v[ps][3];
        }
    }
    __syncthreads();
    {
        const int n = tid & 63, kc = (tid >> 6) * 32;
        bf16_t* dst = Bt + (size_t)(tn * 64 + n) * K + tk * 128 + kc;
#pragma unroll
        for (int q = 0; q < 4; ++q) {
            u32x4 w;
            w.x = pk_bf16(tile[(kc + q * 8 + 0) * 65 + n], tile[(kc + q * 8 + 1) * 65 + n]);
            w.y = pk_bf16(tile[(kc + q * 8 + 2) * 65 + n], tile[(kc + q * 8 + 3) * 65 + n]);
            w.z = pk_bf16(tile[(kc + q * 8 + 4) * 65 + n], tile[(kc + q * 8 + 5) * 65 + n]);
            w.w = pk_bf16(tile[(kc + q * 8 + 6) * 65 + n], tile[(kc + q * 8 + 7) * 65 + n]);
            *(u32x4*)(dst + q * 8) = w;
        }
    }
    __syncthreads();
}

DEVI void norm_phase(const float* __restrict__ srcP, const float* __restrict__ srcS, const float* __restrict__ gain, bf16_t* __restrict__ H, float* __restrict__ Xcopy) {
    const int lane = tid_() & 63;
    const int gw = blockIdx.x * 4 + (tid_() >> 6), nw = gridDim.x * 4;
    f32x4 g4[4];
#pragma unroll
    for (int i = 0; i < 4; ++i) g4[i] = *(const f32x4*)(gain + i * 256 + lane * 4);
    for (int r = gw; r < MT; r += nw) {
        const float* src = (r < NPR) ? srcP + (size_t)r * DM : srcS + (size_t)(r - NPR) * DM;
        f32x4 v[4];
        float ss = 0.f;
#pragma unroll
        for (int i = 0; i < 4; ++i) { v[i] = *(const f32x4*)(src + i * 256 + lane * 4); ss += v[i][0] * v[i][0] + v[i][1] * v[i][1] + v[i][2] * v[i][2] + v[i][3] * v[i][3]; }
        ss = wave_sum(ss);
        const float rstd = rsqrtf(ss * (1.0f / DM) + EPS);
#pragma unroll
        for (int i = 0; i < 4; ++i) {
            st_bf4(H + (size_t)r * DM + i * 256 + lane * 4, v[i] * rstd * g4[i]);
            if (Xcopy) *(f32x4*)(Xcopy + (size_t)r * DM + i * 256 + lane * 4) = v[i];
        }
    }
}

DEVI void phase0(CP p, unsigned char* smem) {
    float* tile = (float*)smem;
    {
        constexpr int T0 = 848, T1 = T0 + 704, T2 = T1 + 352, T3 = T2 + 128, T4 = T3 + 128, T5 = T4 + 64, T6 = T5 + 64, T7 = T6 + 64, T8 = T7 + 32;
        for (int u = blockIdx.x; u < 2 * T8; u += gridDim.x) {
            const int l = u / T8, r = u - l * T8;
            if (r < T0)      { const int t = r;      conv_tile(p->w_in + (size_t)l * DM * INSRC, INSRC, DM, p->Win + (size_t)l * NIN * DM, 1, t % 106, t / 106, tile); }
            else if (r < T1) { const int t = r - T0; conv_tile(p->w_ffn_in + (size_t)l * DM * NFFI, NFFI, DM, p->Wffi + (size_t)l * NFFI * DM, 2, t % 88, t / 88, tile); }
            else if (r < T2) { const int t = r - T1; conv_tile(p->w_ffn_out + (size_t)l * DFF * DM, DM, DFF, p->Wffo + (size_t)l * DM * DFF, 0, t % 16, t / 16, tile); }
            else if (r < T3) { const int t = r - T2; conv_tile(p->w_out + (size_t)l * DM * DM, DM, DM, p->Wout + (size_t)l * DM * DM, 0, t % 16, t / 16, tile); }
            else if (r < T4) { const int t = r - T3; conv_tile(p->w_ple_gate + (size_t)l * DM * DM, DM, DM, p->Wpg + (size_t)l * DM * DM, 0, t % 16, t / 16, tile); }
            else if (r < T5) { const int t = r - T4; conv_tile(p->w_br_a + (size_t)l * 512 * DM, DM, 512, p->Wa + (size_t)l * DM * 512, 0, t % 16, t / 16, tile); }
            else if (r < T6) { const int t = r - T5; conv_tile(p->w_br_b + (size_t)l * 512 * DM, DM, 512, p->Wb + (size_t)l * DM * 512, 0, t % 16, t / 16, tile); }
            else if (r < T7) { const int t = r - T6; conv_tile(p->w_br_c + (size_t)l * 512 * DM, DM, 512, p->Wc + (size_t)l * DM * 512, 0, t % 16, t / 16, tile); }
            else             { const int t = r - T7; conv_tile(p->w_ple_proj + (size_t)l * 256 * DM, DM, 256, p->Wpp + (size_t)l * DM * 256, 0, t % 16, t / 16, tile); }
        }
    }
    const int gt = blockIdx.x * 256 + tid_(), nt = gridDim.x * 256;
    for (int e = gt; e < 2 * 4 * 128 * 128; e += nt) {
        const int j = e & 127, i = (e >> 7) & 127;
        const float v = ((j >> 6) <= (i >> 6)) ? p->a_ws[e] : 0.f;
        p->WS[e] = (bf16_t)(pk_bf16(v, 0.f) & 0xffffu);
    }
    for (int e = gt; e < 2 * MT * 64; e += nt) {
        const int c4 = (e & 63) * 4, r = (e >> 6) % MT, l = (e >> 6) / MT;
        const float* src = (r < NPR) ? p->p_prompt + ((size_t)(l * NPR + r)) * 256 + c4 : p->p_sample + ((size_t)(l * NSM + r - NPR)) * 256 + c4;
        st_bf4(p->P + ((size_t)(l * MT + r)) * 256 + c4, __builtin_nontemporal_load((const f32x4*)src));
    }
    norm_phase(p->x_prompt, p->x_sample, p->norm_mix, p->H, nullptr);
}

DEVI void phase_gemm_in(CP p, int l, unsigned char* smem, unsigned char* smem1) {
    const int tid = tid_(), lane = tid & 63, wid = tid >> 6, wr = wid >> 1, wc = wid & 1, fr = lane & 15, fq = lane >> 4;
    constexpr int NCT = NIN / 128;
    TileMap tm; tm.init(NPR / 128, NCT);
    const int nmain = (tm.total - tm.j + tm.J - 1) / tm.J;
    int extra = -1;
    if (tm.x >= 0) { const int j0 = tm.total % tm.J; if (tm.j >= j0) { const int k = (tm.j - j0) * 8 + tm.x; if (k < 2 * NCT) extra = k; } }
    else tm.init(MT / 128, NCT);
    const int nmain2 = (tm.total - tm.j + tm.J - 1) / tm.J;
    const int niter = (tm.x >= 0 ? nmain : nmain2) + (extra >= 0 ? 1 : 0);
    for (int it = 0; it < niter; ++it) {
        int ct, rt;
        if (extra < 0 || it + 1 < niter) tm.get(tm.j + it * tm.J, rt, ct);
        else { rt = NPR / 128 + extra / NCT; ct = extra % NCT; }
        f32x4 acc[4][4];
        zero_acc<4>(acc);
        gemm_acc<4>(acc, p->H + (size_t)rt * 128 * DM, DM, p->Win + ((size_t)l * NIN + ct * 128) * DM, DM, DM, smem, smem1);
        const int rbase = rt * 128 + wr * 64 + fr;
        const int cw = wc * 64 + fq * 4;
        if (ct < 8) {
            bf16_t* dst = (ct < 4) ? p->AU : p->AVp;
            const int cb = (ct & 3) * 128 + cw;
#pragma unroll
            for (int m = 0; m < 4; ++m)
#pragma unroll
                for (int n = 0; n < 4; ++n) {
                    f32x4 v = acc[m][n];
                    v[0] = gelu_tanh(v[0]); v[1] = gelu_tanh(v[1]); v[2] = gelu_tanh(v[2]); v[3] = gelu_tanh(v[3]);
                    st_bf4(dst + (size_t)(rbase + m * 16) * 512 + cb + n * 16, v);
                }
        } else if (ct < 13) {
            const float* gn = (ct < 12) ? p->b_qnorm + l * 64 : p->b_knorm + l * 64;
            f32x4 g4[4];
#pragma unroll
            for (int n = 0; n < 4; ++n) g4[n] = *(const f32x4*)(gn + n * 16 + fq * 4);
#pragma unroll
            for (int m = 0; m < 4; ++m) {
                float ss = 0.f;
#pragma unroll
                for (int n = 0; n < 4; ++n) { const f32x4 v = acc[m][n]; ss += v[0] * v[0] + v[1] * v[1] + v[2] * v[2] + v[3] * v[3]; }
                ss += __shfl_xor(ss, 16); ss += __shfl_xor(ss, 32);
                const float rstd = rsqrtf(ss * (1.0f / 64.0f) + EPS);
                const int row = rbase + m * 16;
#pragma unroll
                for (int n = 0; n < 4; ++n) {
                    const f32x4 v = acc[m][n] * rstd * g4[n];
                    if (ct < 12) st_bf4(p->BQ + (size_t)row * 512 + (ct - 8) * 128 + cw + n * 16, v);
                    else {
                        st_bf4(p->BK + (size_t)row * 128 + cw + n * 16, v);
                        __builtin_nontemporal_store(v, (f32x4*)(state_out(p->out, O_BKP, O_BKS, l, row, 128) + cw + n * 16));
                    }
                }
            }
        } else if (ct == 13) {
#pragma unroll
            for (int m = 0; m < 4; ++m)
#pragma unroll
                for (int n = 0; n < 4; ++n) {
                    const int row = rbase + m * 16;
                    st_bf4(p->BV + (size_t)row * 128 + cw + n * 16, acc[m][n]);
                    __builtin_nontemporal_store(acc[m][n], (f32x4*)(state_out(p->out, O_BVP, O_BVS, l, row, 128) + cw + n * 16));
                }
        } else if (ct < 16) {
#pragma unroll
            for (int m = 0; m < 4; ++m)
#pragma unroll
                for (int n = 0; n < 4; ++n) st_bf4(p->IQ + (size_t)(rbase + m * 16) * 256 + (ct - 14) * 128 + cw + n * 16, acc[m][n]);
        } else if (ct == 16) {
#pragma unroll
            for (int m = 0; m < 4; ++m)
#pragma unroll
                for (int n = 0; n < 4; ++n) {
                    const int row = rbase + m * 16, c = cw + n * 16;
                    if (c < 32) {
                        st_bf4(p->IK + (size_t)row * 32 + c, acc[m][n]);
                        __builtin_nontemporal_store(acc[m][n], (f32x4*)(state_out(p->out, O_IKP, O_IKS, l, row, 32) + c));
                    } else if (c < 40) {
                        *(f32x4*)(p->IW + (size_t)row * 8 + (c - 32)) = acc[m][n] * 0.35355339059327373f;
                    }
                }
        } else if (ct < 29) {
            const int seg = (ct - 17) >> 2, cb = ((ct - 17) & 3) * 128 + cw;
            bf16_t* dst = (seg == 0) ? p->CQ : (seg == 1) ? p->CK : p->CV;
#pragma unroll
            for (int m = 0; m < 4; ++m)
#pragma unroll
                for (int n = 0; n < 4; ++n) {
                    const int row = rbase + m * 16;
                    st_bf4(dst + (size_t)row * 512 + cb + n * 16, acc[m][n]);
                    if (seg == 1) __builtin_nontemporal_store(acc[m][n], (f32x4*)(state_out(p->out, O_CKP, O_CKS, l, row, 512) + cb + n * 16));
                    if (seg == 2) __builtin_nontemporal_store(acc[m][n], (f32x4*)(state_out(p->out, O_CVP, O_CVS, l, row, 512) + cb + n * 16));
                }
        } else {
            const int cb = (ct - 29) * 128 + cw;
#pragma unroll
            for (int n = 0; n < 4; ++n) {
                const f32x4 gb = *(const f32x4*)(p->gate_bias + l * 3072 + cb + n * 16);
#pragma unroll
                for (int m = 0; m < 4; ++m) {
                    f32x4 v = acc[m][n] + gb;
                    v[0] = sigmoidf_(v[0]); v[1] = sigmoidf_(v[1]); v[2] = sigmoidf_(v[2]); v[3] = sigmoidf_(v[3]);
                    st_bf4(p->G + (size_t)(rbase + m * 16) * 3072 + cb + n * 16, v);
                }
            }
        }
    }
}

DEVI void amix_unit(CP p, int l, int ch, int g, unsigned char* smem) {
    bf16_t* Vt = (bf16_t*)smem;
    float* rs = (float*)(smem + 128 * 136 * 2);
    const int tid = tid_(), lane = tid & 63, w = tid >> 6, fr = lane & 15, fq = lane >> 4;
    int row0, nvalid;
    if (ch < 128) { row0 = ch * 128; nvalid = 128; } else { row0 = NPR + (ch - 128) * 16; nvalid = 16; }
    {
        const int r = tid >> 1, hf = tid & 1;
        float ss = 0.f;
        if (r < nvalid) {
            const u32x4* src = (const u32x4*)(p->AVp + (size_t)(row0 + r) * 512 + hf * 256);
            for (int i = 0; i < 32; ++i) {
                const u32x4 v = src[i];
#pragma unroll
                for (int c = 0; c < 4; ++c) { const float a = bf_lo(v[c]), b = bf_hi(v[c]); ss += a * a + b * b; }
            }
        }
        ss += __shfl_xor(ss, 1);
        if (hf == 0) rs[r] = (r < nvalid) ? rsqrtf(ss * (1.0f / 512.0f) + EPS) : 0.f;
    }
    __syncthreads();
    {
        const int j = tid >> 1, dh = (tid & 1) * 64;
        const float rj = rs[j];
        for (int c8 = 0; c8 < 8; ++c8) {
            const int d0 = dh + c8 * 8;
            float v[8];
            if (j < nvalid) {
                const u32x4 raw = *(const u32x4*)(p->AVp + (size_t)(row0 + j) * 512 + g * 128 + d0);
                const f32x4 g0 = *(const f32x4*)(p->a_vnorm + l * 512 + g * 128 + d0), g1 = *(const f32x4*)(p->a_vnorm + l * 512 + g * 128 + d0 + 4);
                v[0] = bf_lo(raw.x) * rj * g0[0]; v[1] = bf_hi(raw.x) * rj * g0[1]; v[2] = bf_lo(raw.y) * rj * g0[2]; v[3] = bf_hi(raw.y) * rj * g0[3];
                v[4] = bf_lo(raw.z) * rj * g1[0]; v[5] = bf_hi(raw.z) * rj * g1[1]; v[6] = bf_lo(raw.w) * rj * g1[2]; v[7] = bf_hi(raw.w) * rj * g1[3];
                if (ch >= 128) {
                    float* o = p->out + O_AVS + (size_t)(l * NSM + (ch - 128) * 16 + j) * 512 + g * 128 + d0;
                    *(f32x4*)o = (f32x4){v[0], v[1], v[2], v[3]};
                    *(f32x4*)(o + 4) = (f32x4){v[4], v[5], v[6], v[7]};
                }
            } else {
#pragma unroll
                for (int e = 0; e < 8; ++e) v[e] = 0.f;
            }
#pragma unroll
            for (int e = 0; e < 8; e += 2) {
                const unsigned pk = pk_bf16(v[e], v[e + 1]);
                Vt[(d0 + e) * 136 + j] = (bf16_t)(pk & 0xffffu);
                Vt[(d0 + e + 1) * 136 + j] = (bf16_t)(pk >> 16);
            }
        }
    }
    __syncthreads();
    f32x4 acc[2][8];
#pragma unroll
    for (int mi = 0; mi < 2; ++mi)
#pragma unroll
        for (int dn = 0; dn < 8; ++dn) acc[mi][dn] = (f32x4){0.f, 0.f, 0.f, 0.f};
    const bf16_t* Wg = p->WS + (size_t)(l * 4 + g) * 128 * 128;
#pragma unroll
    for (int kk = 0; kk < 4; ++kk) {
        bf16x8 wf[2];
#pragma unroll
        for (int mi = 0; mi < 2; ++mi) wf[mi] = *(const bf16x8*)(Wg + (w * 32 + mi * 16 + fr) * 128 + kk * 32 + fq * 8);
#pragma unroll
        for (int dn = 0; dn < 8; ++dn) {
            const bf16x8 vf = *(const bf16x8*)(Vt + (dn * 16 + fr) * 136 + kk * 32 + fq * 8);
#pragma unroll
            for (int mi = 0; mi < 2; ++mi) acc[mi][dn] = mfma16(vf, wf[mi], acc[mi][dn]);
        }
    }
#pragma unroll
    for (int mi = 0; mi < 2; ++mi) {
        const int i = w * 32 + mi * 16 + fr;
        if (i < nvalid) {
            const int row = row0 + i;
            const float bias = p->a_bias[(l * 4 + g) * 128 + i];
#pragma unroll
            for (int dn = 0; dn < 8; ++dn) {
                const int d = dn * 16 + fq * 4;
                const u32x2 uu = *(const u32x2*)(p->AU + (size_t)row * 512 + g * 128 + d);
                f32x4 o;
                o[0] = bf_lo(uu.x) * (acc[mi][dn][0] + bias); o[1] = bf_hi(uu.x) * (acc[mi][dn][1] + bias);
                o[2] = bf_lo(uu.y) * (acc[mi][dn][2] + bias); o[3] = bf_hi(uu.y) * (acc[mi][dn][3] + bias);
                st_bf4(p->OA + (size_t)row * 512 + g * 128 + d, o);
            }
        }
    }
    __syncthreads();
}

template <bool SAMPLE> DEVI bf16x8 load_ik(CP p, int l, int b, int kpos, int off) {
    if (!SAMPLE) return *(const bf16x8*)(p->IK + (size_t)(b * SEQ + kpos) * 32 + off);
    const float* src;
    if (kpos < PAST) src = p->cache_b_kidx + ((size_t)(l * 16 + b) * PAST + kpos) * 32 + off;
    else if (kpos < PAST + 16) src = p->out + O_IKS + (size_t)(l * NSM + b * 16 + kpos - PAST) * 32 + off;
    else return zero8();
    return pack8(*(const f32x4*)src, *(const f32x4*)(src + 4));
}
template <bool SAMPLE> DEVI const float* kv_f32_ptr(CP p, const float* cache, int offS, int l, int b, int kidx, int kh, int off) {
    if (kidx < PAST) return cache + (((size_t)(l * 16 + b) * PAST + kidx) * 2 + kh) * 64 + off;
    return p->out + offS + ((size_t)(l * NSM + b * 16 + kidx - PAST) * 2 + kh) * 64 + off;
}

template <int NS> DEVI int select_topk(const unsigned* ukl, int* idxl, int lane, int nkeys) {
    unsigned k[NS];
#pragma unroll
    for (int i = 0; i < NS; ++i) k[i] = ukl[i * 64 + lane];
    unsigned T = 0u;
    int tie_cut = 0x7fffffff;
    bool take_eq = false;
    if (nkeys > 256) {
        for (int bit = 31; bit >= 0; --bit) {
            const unsigned cand = T | (1u << bit);
            int cnt = 0;
#pragma unroll
            for (int i = 0; i < NS; ++i) cnt += __popcll(__ballot(k[i] >= cand));
            if (cnt >= 256) T = cand;
            if (cnt == 256) break;
        }
        int cgt = 0, ceq = 0;
#pragma unroll
        for (int i = 0; i < NS; ++i) { cgt += __popcll(__ballot(k[i] > T)); ceq += __popcll(__ballot(k[i] == T)); }
        const int need = 256 - cgt;
        take_eq = need > 0;
        if (need > 0 && need < ceq) {
            int cur = -1;
            for (int it = 0; it < need; ++it) {
                int mn = 0x7fffffff;
#pragma unroll
                for (int i = 0; i < NS; ++i) { const int id = i * 64 + lane; if (k[i] == T && id > cur && id < mn) mn = id; }
                cur = wave_min_i(mn);
            }
            tie_cut = cur;
        }
    }
    int cl = 0;
#pragma unroll
    for (int i = 0; i < NS; ++i) {
        const bool sel = (k[i] > T) || (take_eq && k[i] == T && (i * 64 + lane) <= tie_cut);
        cl += sel ? 1 : 0;
    }
    int pre = cl;
#pragma unroll
    for (int o = 1; o < 64; o <<= 1) { const int t = __shfl_up(pre, o); if (lane >= o) pre += t; }
    const int base = __builtin_amdgcn_readfirstlane(__shfl(pre, 63));
    int pos = pre - cl;
#pragma unroll
    for (int i = 0; i < NS; ++i) {
        const bool sel = (k[i] > T) || (take_eq && k[i] == T && (i * 64 + lane) <= tie_cut);
        if (sel) { if (pos < 256) idxl[pos] = i * 64 + lane; ++pos; }
    }
    return base;
}

template <bool SAMPLE> DEVI void dsa_query(CP p, int l, int qrow, unsigned* ukl, int* idxl) {
    float* wl = (float*)ukl;
    qrow = __builtin_amdgcn_readfirstlane(qrow);
    const int lane = tid_() & 63, fr = lane & 15, fq = lane >> 4;
    int b, nmain, nsl, nkeys;
    if (!SAMPLE) { b = qrow >> 12; const int t = qrow & 4095; nmain = (t >> 6) + 1; nsl = nmain; nkeys = nmain * 64; }
    else { b = (qrow - NPR) >> 4; nmain = 64; nsl = 65; nkeys = PAST + 16; }
    const bf16x8 qa = *(const bf16x8*)(p->IQ + (size_t)qrow * 256 + (fr & 7) * 32 + fq * 8);
    const f32x4 w4 = *(const f32x4*)(p->IW + (size_t)qrow * 8 + (fq & 1) * 4) * 0.17677669529663687f;
    constexpr int SPI = SAMPLE ? 1 : 2;
    constexpr int GPI = SPI * 4;
    const int niter = (nmain + SPI - 1) / SPI;
    const bf16_t* kpb = p->IK + (size_t)(b * SEQ + fr) * 32 + fq * 8;
    const float* kpf = p->cache_b_kidx + ((size_t)(l * 16 + b) * PAST + fr) * 32 + fq * 8;
    bf16x8 cur[GPI], nxt[GPI];
#pragma unroll
    for (int g = 0; g < GPI; ++g) {
        if (!SAMPLE) cur[g] = *(const bf16x8*)(kpb + g * 512);
        else cur[g] = pack8(*(const f32x4*)(kpf + g * 512), *(const f32x4*)(kpf + g * 512 + 4));
    }
    for (int it = 0; it < niter; ++it) {
        kpb += GPI * 512; kpf += GPI * 512;
        if (it + 1 < niter) {
#pragma unroll
            for (int g = 0; g < GPI; ++g) {
                if (!SAMPLE) nxt[g] = *(const bf16x8*)(kpb + g * 512);
                else nxt[g] = pack8(*(const f32x4*)(kpf + g * 512), *(const f32x4*)(kpf + g * 512 + 4));
            }
        }
        float sg[GPI], tg[GPI];
#pragma unroll
        for (int g = 0; g < GPI; ++g) {
            const f32x4 d = mfma16(qa, cur[g], (f32x4){0.f, 0.f, 0.f, 0.f});
            float s_ = __builtin_amdgcn_fmed3f(d[0], 0.f, 3.0e38f) * w4[0];
            s_ = fmaf(__builtin_amdgcn_fmed3f(d[1], 0.f, 3.0e38f), w4[1], s_);
            s_ = fmaf(__builtin_amdgcn_fmed3f(d[2], 0.f, 3.0e38f), w4[2], s_);
            s_ = fmaf(__builtin_amdgcn_fmed3f(d[3], 0.f, 3.0e38f), w4[3], s_);
            sg[g] = s_;
        }
#pragma unroll
        for (int g = 0; g < GPI; ++g) tg[g] = __shfl_xor(sg[g], 16);
#pragma unroll
        for (int sl = 0; sl < SPI; ++sl) {
            float sc = 0.f;
#pragma unroll
            for (int g = 0; g < 4; ++g) { const float v = sg[sl * 4 + g] + tg[sl * 4 + g]; if (fq == g) sc = v; }
            sc += 0.0f;
            const unsigned u = __float_as_uint(sc);
            ukl[(it * SPI + sl) * 64 + lane] = (u & 0x80000000u) ? ~u : (u | 0x80000000u);
        }
#pragma unroll
        for (int g = 0; g < GPI; ++g) cur[g] = nxt[g];
    }
    if (SAMPLE) {
        const float* src = p->out + O_IKS + (size_t)(l * NSM + b * 16 + fr) * 32 + fq * 8;
        const bf16x8 kb = pack8(*(const f32x4*)src, *(const f32x4*)(src + 4));
        const f32x4 d = mfma16(qa, kb, (f32x4){0.f, 0.f, 0.f, 0.f});
        float s = __builtin_amdgcn_fmed3f(d[0], 0.f, 3.0e38f) * w4[0];
        s = fmaf(__builtin_amdgcn_fmed3f(d[1], 0.f, 3.0e38f), w4[1], s);
        s = fmaf(__builtin_amdgcn_fmed3f(d[2], 0.f, 3.0e38f), w4[2], s);
        s = fmaf(__builtin_amdgcn_fmed3f(d[3], 0.f, 3.0e38f), w4[3], s);
        s += __shfl_xor(s, 16);
        s += 0.0f;
        const unsigned u = __float_as_uint(s);
        const unsigned key = (u & 0x80000000u) ? ~u : (u | 0x80000000u);
        ukl[64 * 64 + lane] = (fq == 0) ? key : 0u;
    }
    int base;
    if (SAMPLE) base = select_topk<65>(ukl, idxl, lane, nkeys);
    else {
        const int ns16 = (nsl + 15) & ~15;
        for (int i = nsl; i < ns16; ++i) ukl[i * 64 + lane] = 0u;
        if (ns16 == 16) base = select_topk<16>(ukl, idxl, lane, nkeys);
        else if (ns16 == 32) base = select_topk<32>(ukl, idxl, lane, nkeys);
        else if (ns16 == 48) base = select_topk<48>(ukl, idxl, lane, nkeys);
        else base = select_topk<64>(ukl, idxl, lane, nkeys);
    }
    const int nsel = base < 256 ? base : 256;
    const int ngr = (nsel + 15) >> 4;
    wave_sync();
    {
        constexpr int GL = SAMPLE ? 2 : 4;
        bf16x8 qf[2][2];
#pragma unroll
        for (int kh = 0; kh < 2; ++kh)
#pragma unroll
            for (int ks = 0; ks < 2; ++ks) {
                qf[kh][ks] = zero8();
                if (fr < 4) qf[kh][ks] = *(const bf16x8*)(p->BQ + (size_t)qrow * 512 + (kh * 4 + fr) * 64 + ks * 32 + fq * 8);
            }
        for (int gi0 = 0; gi0 < ngr; gi0 += GL) {
            bf16x8 kb[GL][2][2];
#pragma unroll
            for (int j = 0; j < GL; ++j) {
                const int n = (gi0 + j) * 16 + fr;
                const int kidx = (n < nsel) ? idxl[n] : 0;
#pragma unroll
                for (int kh = 0; kh < 2; ++kh)
#pragma unroll
                    for (int ks = 0; ks < 2; ++ks) {
                        if (!SAMPLE) kb[j][kh][ks] = *(const bf16x8*)(p->BK + (size_t)(b * SEQ + kidx) * 128 + kh * 64 + ks * 32 + fq * 8);
                        else { const float* s_ = kv_f32_ptr<SAMPLE>(p, p->cache_b_k, O_BKS, l, b, kidx, kh, ks * 32 + fq * 8); kb[j][kh][ks] = pack8(*(const f32x4*)s_, *(const f32x4*)(s_ + 4)); }
                    }
            }
#pragma unroll
            for (int j = 0; j < GL; ++j) {
                const int n = (gi0 + j) * 16 + fr;
#pragma unroll
                for (int kh = 0; kh < 2; ++kh) {
                    f32x4 d = (f32x4){0.f, 0.f, 0.f, 0.f};
                    d = mfma16(qf[kh][0], kb[j][kh][0], d);
                    d = mfma16(qf[kh][1], kb[j][kh][1], d);
                    if (fq == 0 && gi0 + j < ngr) {
                        f32x4 v = d * 0.125f;
                        if (n >= nsel) v = (f32x4){-INFINITY, -INFINITY, -INFINITY, -INFINITY};
                        *(f32x4*)(wl + (kh * 256 + n) * 4) = v;
                    }
                }
            }
        }
    }
    wave_sync();
#pragma unroll
    for (int kh = 0; kh < 2; ++kh) {
        f32x4 x[4];
        f32x4 mx = (f32x4){-INFINITY, -INFINITY, -INFINITY, -INFINITY};
#pragma unroll
        for (int k = 0; k < 4; ++k) {
            const int n = lane + 64 * k;
            x[k] = (n < ngr * 16) ? *(const f32x4*)(wl + (kh * 256 + n) * 4) : (f32x4){-INFINITY, -INFINITY, -INFINITY, -INFINITY};
#pragma unroll
            for (int c = 0; c < 4; ++c) mx[c] = fmaxf(mx[c], x[k][c]);
        }
#pragma unroll
        for (int c = 0; c < 4; ++c) mx[c] = wave_max(mx[c]);
        f32x4 sm = (f32x4){0.f, 0.f, 0.f, 0.f};
#pragma unroll
        for (int k = 0; k < 4; ++k)
#pragma unroll
            for (int c = 0; c < 4; ++c) { x[k][c] = __expf(x[k][c] - mx[c]); sm[c] += x[k][c]; }
#pragma unroll
        for (int c = 0; c < 4; ++c) sm[c] = 1.0f / wave_sum(sm[c]);
#pragma unroll
        for (int k = 0; k < 4; ++k) {
            const int n = lane + 64 * k;
            if (n < ngr * 16) *(f32x4*)(wl + (kh * 256 + n) * 4) = x[k] * sm;
        }
    }
    wave_sync();
    const int kq = lane >> 3, dc = lane & 7;
#pragma unroll
    for (int kh = 0; kh < 2; ++kh) {
        float o[4][8];
#pragma unroll
        for (int hh = 0; hh < 4; ++hh)
#pragma unroll
            for (int e = 0; e < 8; ++e) o[hh][e] = 0.f;
        constexpr int KB = SAMPLE ? 4 : 8;
        constexpr int RW = SAMPLE ? 2 : 1;
        f32x4 ppC[KB], ppN[KB];
        u32x4 rwC[KB][RW], rwN[KB][RW];
#define PV_LOAD(n0_, PP_, RW_) do { \
        _Pragma("unroll") for (int j = 0; j < KB; ++j) { \
            const int n = (n0_) + 8 * j; \
            const bool ok = n < nsel; \
            const int kidx = ok ? idxl[n] : 0; \
            PP_[j] = ok ? *(const f32x4*)(wl + (kh * 256 + n) * 4) : (f32x4){0.f, 0.f, 0.f, 0.f}; \
            if (!SAMPLE) RW_[j][0] = *(const u32x4*)(p->BV + (size_t)(b * SEQ + kidx) * 128 + kh * 64 + dc * 8); \
            else { const float* s_ = kv_f32_ptr<SAMPLE>(p, p->cache_b_v, O_BVS, l, b, kidx, kh, dc * 8); \
                   RW_[j][0] = *(const u32x4*)s_; RW_[j][RW - 1] = *(const u32x4*)(s_ + 4); } \
        } } while (0)
        PV_LOAD(kq, ppC, rwC);
        for (int n0 = kq; n0 < nsel; n0 += 8 * KB) {
            if (n0 + 8 * KB < nsel) PV_LOAD(n0 + 8 * KB, ppN, rwN);
#pragma unroll
            for (int j = 0; j < KB; ++j) {
                float v[8];
                if (!SAMPLE) {
                    v[0] = bf_lo(rwC[j][0].x); v[1] = bf_hi(rwC[j][0].x); v[2] = bf_lo(rwC[j][0].y); v[3] = bf_hi(rwC[j][0].y);
                    v[4] = bf_lo(rwC[j][0].z); v[5] = bf_hi(rwC[j][0].z); v[6] = bf_lo(rwC[j][0].w); v[7] = bf_hi(rwC[j][0].w);
                } else {
                    v[0] = __uint_as_float(rwC[j][0].x); v[1] = __uint_as_float(rwC[j][0].y); v[2] = __uint_as_float(rwC[j][0].z); v[3] = __uint_as_float(rwC[j][0].w);
                    v[4] = __uint_as_float(rwC[j][RW - 1].x); v[5] = __uint_as_float(rwC[j][RW - 1].y); v[6] = __uint_as_float(rwC[j][RW - 1].z); v[7] = __uint_as_float(rwC[j][RW - 1].w);
                }
#pragma unroll
                for (int hh = 0; hh < 4; ++hh)
#pragma unroll
                    for (int e = 0; e < 8; ++e) o[hh][e] = fmaf(ppC[j][hh], v[e], o[hh][e]);
            }
#pragma unroll
            for (int j = 0; j < KB; ++j) { ppC[j] = ppN[j];
#pragma unroll
                for (int q = 0; q < RW; ++q) rwC[j][q] = rwN[j][q]; }
        }
#undef PV_LOAD
#pragma unroll
        for (int hh = 0; hh < 4; ++hh)
#pragma unroll
            for (int e = 0; e < 8; ++e) {
                float t = o[hh][e];
                t += __shfl_xor(t, 8); t += __shfl_xor(t, 16); t += __shfl_xor(t, 32);
                o[hh][e] = t;
            }
        if (kq == 0) {
#pragma unroll
            for (int hh = 0; hh < 4; ++hh) {
                u32x4 w;
                w.x = pk_bf16(o[hh][0], o[hh][1]); w.y = pk_bf16(o[hh][2], o[hh][3]); w.z = pk_bf16(o[hh][4], o[hh][5]); w.w = pk_bf16(o[hh][6], o[hh][7]);
                *(u32x4*)(p->OB + (size_t)qrow * 512 + (kh * 4 + hh) * 64 + dc * 8) = w;
            }
        }
    }
    wave_sync();
}

template <bool SAMPLE> DEVI void stick_unit(CP p, int l, int b, int h, int qt, unsigned char* smem) {
    bf16_t* Ks = (bf16_t*)smem;
    bf16_t* Vt = Ks + 64 * 72;
    bf16_t* Wl = Vt + 64 * 72;
    int* flags = (int*)(Wl + 4 * 16 * 72);
    const int tid = tid_(), lane = tid & 63, w = tid >> 6, fr = lane & 15, fq = lane >> 4;
    bf16_t* Ww = Wl + w * 16 * 72;
    int qrow_a, tbase, k0;
    if (!SAMPLE) { qrow_a = b * SEQ + qt * 64 + w * 16; tbase = qt * 64 + w * 16; k0 = qt * 64; }
    else { qrow_a = NPR + b * 16; tbase = PAST; k0 = PAST; }
    bf16x8 qf[2];
#pragma unroll
    for (int ks = 0; ks < 2; ++ks) qf[ks] = *(const bf16x8*)(p->CQ + (size_t)(qrow_a + fr) * 512 + h * 64 + ks * 32 + fq * 8);
    float R[4] = {0.f, 0.f, 0.f, 0.f};
    f32x4 O[4];
#pragma unroll
    for (int dt = 0; dt < 4; ++dt) O[dt] = (f32x4){0.f, 0.f, 0.f, 0.f};
    for (; k0 >= 0; k0 -= 64) {
        {
            const int key = tid >> 2, part = (tid & 3) * 16;
            u32x4 kr0, kr1, vr0, vr1;
            if (!SAMPLE) {
                const bf16_t* ks_ = p->CK + (size_t)(b * SEQ + k0 + key) * 512 + h * 64 + part;
                const bf16_t* vs_ = p->CV + (size_t)(b * SEQ + k0 + key) * 512 + h * 64 + part;
                kr0 = *(const u32x4*)ks_; kr1 = *(const u32x4*)(ks_ + 8);
                vr0 = *(const u32x4*)vs_; vr1 = *(const u32x4*)(vs_ + 8);
            } else {
                const int pos = k0 + key;
                const float *kp = nullptr, *vp = nullptr;
                if (pos < PAST) {
                    const size_t o = (((size_t)(l * 16 + b) * PAST + pos) * 8 + h) * 64 + part;
                    kp = p->cache_c_k + o; vp = p->cache_c_v + o;
                } else if (pos < PAST + 16) {
                    const size_t o = ((size_t)(l * NSM + b * 16 + pos - PAST) * 8 + h) * 64 + part;
                    kp = p->out + O_CKS + o; vp = p->out + O_CVS + o;
                }
                if (kp) {
                    const f32x4 a0 = *(const f32x4*)kp, a1 = *(const f32x4*)(kp + 4), a2 = *(const f32x4*)(kp + 8), a3 = *(const f32x4*)(kp + 12);
                    const f32x4 c0 = *(const f32x4*)vp, c1 = *(const f32x4*)(vp + 4), c2 = *(const f32x4*)(vp + 8), c3 = *(const f32x4*)(vp + 12);
                    kr0 = __builtin_bit_cast(u32x4, pack8(a0, a1)); kr1 = __builtin_bit_cast(u32x4, pack8(a2, a3));
                    vr0 = __builtin_bit_cast(u32x4, pack8(c0, c1)); vr1 = __builtin_bit_cast(u32x4, pack8(c2, c3));
                } else {
                    kr0 = kr1 = vr0 = vr1 = (u32x4){0u, 0u, 0u, 0u};
                }
            }
            *(u32x4*)(Ks + key * 72 + part) = kr0;
            *(u32x4*)(Ks + key * 72 + part + 8) = kr1;
#pragma unroll
            for (int c = 0; c < 4; ++c) {
                Vt[(part + 2 * c) * 72 + key] = (bf16_t)(vr0[c] & 0xffffu);
                Vt[(part + 2 * c + 1) * 72 + key] = (bf16_t)(vr0[c] >> 16);
                Vt[(part + 8 + 2 * c) * 72 + key] = (bf16_t)(vr1[c] & 0xffffu);
                Vt[(part + 8 + 2 * c + 1) * 72 + key] = (bf16_t)(vr1[c] >> 16);
            }
        }
        __syncthreads();
        float wv[4][4];
        float tot[4][4];
        float cs[4][4];
        float zz[4][4];
#pragma unroll
        for (int n = 0; n < 4; ++n) {
            f32x4 s = (f32x4){0.f, 0.f, 0.f, 0.f};
#pragma unroll
            for (int ks = 0; ks < 2; ++ks) {
                const bf16x8 kf = *(const bf16x8*)(Ks + (n * 16 + fr) * 72 + ks * 32 + fq * 8);
                s = mfma16(qf[ks], kf, s);
            }
            const int kpos = k0 + n * 16 + fr;
#pragma unroll
            for (int j = 0; j < 4; ++j) {
                const float z = s[j] * 0.125f;
                const bool mk = kpos < (tbase + fq * 4 + j);
                const float sp = fmaxf(z, 0.f) + __logf(1.0f + __expf(-fabsf(z)));
                float c = mk ? -sp : 0.f;
                zz[n][j] = z;
#pragma unroll
                for (int d = 1; d < 16; d <<= 1) { const float t = __shfl_down(c, d, 16); if (fr + d < 16) c += t; }
                cs[n][j] = c;
                tot[n][j] = __shfl(c, lane & 48);
            }
        }
#pragma unroll
        for (int j = 0; j < 4; ++j) {
            float add = R[j];
#pragma unroll
            for (int n = 3; n >= 0; --n) {
                const int kpos = k0 + n * 16 + fr;
                const bool mk = kpos < (tbase + fq * 4 + j);
                const float e = zz[n][j] + cs[n][j] + add;
                wv[n][j] = mk ? __expf(e) : 0.f;
                add += tot[n][j];
            }
            R[j] = add;
        }
#pragma unroll
        for (int n = 0; n < 4; ++n)
#pragma unroll
            for (int j = 0; j < 4; j += 2) {
                const unsigned pk = pk_bf16(wv[n][j], wv[n][j + 1]);
                Ww[(fq * 4 + j) * 72 + n * 16 + fr] = (bf16_t)(pk & 0xffffu);
                Ww[(fq * 4 + j + 1) * 72 + n * 16 + fr] = (bf16_t)(pk >> 16);
            }
        const bool mine = (R[0] < -30.f) && (R[1] < -30.f) && (R[2] < -30.f) && (R[3] < -30.f);
        const int alldone = __all(mine);
        if (lane == 0) flags[w] = alldone;
        __syncthreads();
#pragma unroll
        for (int ks = 0; ks < 2; ++ks) {
            const bf16x8 wf = *(const bf16x8*)(Ww + fr * 72 + ks * 32 + fq * 8);
#pragma unroll
            for (int dt = 0; dt < 4; ++dt) {
                const bf16x8 vf = *(const bf16x8*)(Vt + (dt * 16 + fr) * 72 + ks * 32 + fq * 8);
                O[dt] = mfma16(wf, vf, O[dt]);
            }
        }
        const int done = flags[0] & flags[1] & flags[2] & flags[3];
        __syncthreads();
        if (done) break;
    }
    if (!SAMPLE || w == 0) {
#pragma unroll
        for (int dt = 0; dt < 4; ++dt)
#pragma unroll
            for (int j = 0; j < 4; j += 2) {
                const unsigned pk = pk_bf16(O[dt][j], O[dt][j + 1]);
                p->OC[(size_t)(qrow_a + fq * 4 + j) * 512 + h * 64 + dt * 16 + fr] = (bf16_t)(pk & 0xffffu);
                p->OC[(size_t)(qrow_a + fq * 4 + j + 1) * 512 + h * 64 + dt * 16 + fr] = (bf16_t)(pk >> 16);
            }
    }
}

constexpr int NI_BS = NSM / 4, NI_BP = NPR / 4, NI_C = 2048 + 128, NI_A = 144 * 4;
constexpr int NI_TOTAL = NI_BS + NI_BP + NI_C + NI_A;
DEVI void phase_mixers(CP p, int l, unsigned char* smem, unsigned char* smem1, int* s_item) {
    const int tid = tid_();
    const int w = __builtin_amdgcn_readfirstlane(tid >> 6);
    unsigned char* wb = (w < 2) ? smem + w * 17664 : smem1 + (w - 2) * 17664;
    unsigned* wl = (unsigned*)wb;
    int* idxl = (int*)(wb + 16640);
    unsigned* ctr = p->bar + XCD_BAR_WORDS + 64 * l;
    if (tid == 0) *s_item = (int)__hip_atomic_fetch_add(ctr, 1u, __ATOMIC_RELAXED, __HIP_MEMORY_SCOPE_AGENT);
    __syncthreads();
    int item = __builtin_amdgcn_readfirstlane(*s_item);
    while (item < NI_TOTAL) {
        int nxt = 0;
        if (tid == 0) nxt = (int)__hip_atomic_fetch_add(ctr, 1u, __ATOMIC_RELAXED, __HIP_MEMORY_SCOPE_AGENT);
        if (item < NI_BS) {
            dsa_query<true>(p, l, NPR + item * 4 + w, wl, idxl);
        } else if (item < NI_BS + NI_BP) {
            const int k = item - NI_BS;
            const int bb = k >> 10, tt = 1023 - (k & 1023);
            dsa_query<false>(p, l, bb * SEQ + tt * 4 + w, wl, idxl);
        } else if (item < NI_BS + NI_BP + NI_C) {
            __syncthreads();
            const int u = item - NI_BS - NI_BP;
            if (u < 2048) { const int h = u & 7, qt = 63 - ((u >> 3) & 63), bb = u >> 9; stick_unit<false>(p, l, bb, h, qt, smem); }
            else { const int v = u - 2048; stick_unit<true>(p, l, v >> 3, v & 7, 0, smem); }
        } else {
            __syncthreads();
            const int u = item - NI_BS - NI_BP - NI_C;
            amix_unit(p, l, u >> 2, u & 3, smem);
        }
        __syncthreads();
        if (tid == 0) *s_item = nxt;
        __syncthreads();
        item = __builtin_amdgcn_readfirstlane(*s_item);
    }
}

template <int NT>
DEVI void phase_merge(CP p, int l, unsigned char* smem, unsigned char* smem1, int rt0, int nrt) {
    const int tid = tid_(), lane = tid & 63, wid = tid >> 6, wr = wid >> 1, wc = wid & 1, fr = lane & 15, fq = lane >> 4;
    constexpr int NCT = DM / (NT * 32);
    TileMap tm; tm.init(nrt, NCT);
    for (int v = tm.j; v < tm.total; v += tm.J) {
        int ct, rt; tm.get(v, rt, ct); rt += rt0;
        f32x4 mg[4][NT];
        zero_acc<NT>(mg);
        const int rbase = rt * 128 + wr * 64 + fr, cb = ct * (NT * 32) + wc * (NT * 16) + fq * 4;
#pragma unroll 1
        for (int br = 0; br < 3; ++br) {
            const bf16_t* A = (br == 0) ? p->OA : (br == 1) ? p->OB : p->OC;
            const bf16_t* W = ((br == 0) ? p->Wa : (br == 1) ? p->Wb : p->Wc) + (size_t)l * DM * 512;
            f32x4 acc[4][NT];
            zero_acc<NT>(acc);
            gemm_acc<NT>(acc, A + (size_t)rt * 128 * 512, 512, W + (size_t)ct * (NT * 32) * 512, 512, 512, smem, smem1);
#pragma unroll
            for (int m = 0; m < 4; ++m)
#pragma unroll
                for (int n = 0; n < NT; ++n) {
                    const u32x2 gg = *(const u32x2*)(p->G + (size_t)(rbase + m * 16) * 3072 + br * 1024 + cb + n * 16);
                    mg[m][n][0] += bf_lo(gg.x) * acc[m][n][0]; mg[m][n][1] += bf_hi(gg.x) * acc[m][n][1];
                    mg[m][n][2] += bf_lo(gg.y) * acc[m][n][2]; mg[m][n][3] += bf_hi(gg.y) * acc[m][n][3];
                }
        }
#pragma unroll
        for (int m = 0; m < 4; ++m)
#pragma unroll
            for (int n = 0; n < NT; ++n) st_bf4(p->MG + (size_t)(rbase + m * 16) * DM + cb + n * 16, mg[m][n]);
    }
}

template <int NT>
DEVI void phase_resid(CP p, const bf16_t* A, int K, const bf16_t* W, bool from_inputs, unsigned char* smem, unsigned char* smem1, int rt0, int nrt) {
    const int tid = tid_(), lane = tid & 63, wid = tid >> 6, wr = wid >> 1, wc = wid & 1, fr = lane & 15, fq = lane >> 4;
    constexpr int NCT = DM / (NT * 32);
    TileMap tm; tm.init(nrt, NCT);
    for (int v = tm.j; v < tm.total; v += tm.J) {
        int ct, rt; tm.get(v, rt, ct); rt += rt0;
        f32x4 acc[4][NT];
        zero_acc<NT>(acc);
        gemm_acc<NT>(acc, A + (size_t)rt * 128 * K, K, W + (size_t)ct * (NT * 32) * K, K, K, smem, smem1);
        const int rbase = rt * 128 + wr * 64 + fr, cb = ct * (NT * 32) + wc * (NT * 16) + fq * 4;
#pragma unroll
        for (int m = 0; m < 4; ++m)
#pragma unroll
            for (int n = 0; n < NT; ++n) {
                const int row = rbase + m * 16;
                float* xp = p->X + (size_t)row * DM + cb + n * 16;
                const float* bp = !from_inputs ? xp : (row < NPR ? p->x_prompt + (size_t)row * DM : p->x_sample + (size_t)(row - NPR) * DM) + cb + n * 16;
                *(f32x4*)xp = *(const f32x4*)bp + acc[m][n];
            }
    }
}

DEVI void phase_ffn_in(CP p, int l, unsigned char* smem, unsigned char* smem1) {
    const int tid = tid_(), lane = tid & 63, wid = tid >> 6, wr = wid >> 1, wc = wid & 1, fr = lane & 15, fq = lane >> 4;
    constexpr int NCT = NFFI / 128, NRT = MT / 128;
    TileMap tm; tm.init(NRT, NCT);
    for (int v = tm.j; v < tm.total; v += tm.J) {
        int ct, rt; tm.get(v, rt, ct);
        f32x4 acc[4][4];
        zero_acc<4>(acc);
        gemm_acc<4>(acc, p->H + (size_t)rt * 128 * DM, DM, p->Wffi + ((size_t)l * NFFI + ct * 128) * DM, DM, DM, smem, smem1);
        const int rbase = rt * 128 + wr * 64 + fr, cb = ct * 64 + wc * 32 + fq * 4;
#pragma unroll
        for (int m = 0; m < 4; ++m)
#pragma unroll
            for (int n = 0; n < 2; ++n) {
                const f32x4 g = acc[m][n], up = acc[m][n + 2];
                f32x4 o;
#pragma unroll
                for (int j = 0; j < 4; ++j) o[j] = g[j] * sigmoidf_(g[j]) * up[j];
                st_bf4(p->ACT + (size_t)(rbase + m * 16) * DFF + cb + n * 16, o);
            }
    }
}

template <int NT>
DEVI void phase_ple(CP p, int l, unsigned char* smem, unsigned char* smem1, int rt0, int nrt) {
    const int tid = tid_(), lane = tid & 63, wid = tid >> 6, wr = wid >> 1, wc = wid & 1, fr = lane & 15, fq = lane >> 4;
    constexpr int NCT = DM / (NT * 32);
    TileMap tm; tm.init(nrt, NCT);
    for (int v = tm.j; v < tm.total; v += tm.J) {
        int ct, rt; tm.get(v, rt, ct); rt += rt0;
        f32x4 sg[4][NT];
        zero_acc<NT>(sg);
        gemm_acc<NT>(sg, p->H + (size_t)rt * 128 * DM, DM, p->Wpg + ((size_t)l * DM + ct * (NT * 32)) * DM, DM, DM, smem, smem1);
#pragma unroll
        for (int m = 0; m < 4; ++m)
#pragma unroll
            for (int n = 0; n < NT; ++n)
#pragma unroll
                for (int j = 0; j < 4; ++j) sg[m][n][j] = sigmoidf_(sg[m][n][j]);
        f32x4 acc[4][NT];
        zero_acc<NT>(acc);
        gemm_acc<NT>(acc, p->P + ((size_t)l * MT + rt * 128) * 256, 256, p->Wpp + ((size_t)l * DM + ct * (NT * 32)) * 256, 256, 256, smem, smem1);
        const int rbase = rt * 128 + wr * 64 + fr, cb = ct * (NT * 32) + wc * (NT * 16) + fq * 4;
#pragma unroll
        for (int m = 0; m < 4; ++m)
#pragma unroll
            for (int n = 0; n < NT; ++n) {
                const int row = rbase + m * 16;
                float* xp = p->X + (size_t)row * DM + cb + n * 16;
                const f32x4 r = *(const f32x4*)xp + sg[m][n] * acc[m][n];
                if (l == 1) __builtin_nontemporal_store(r, (f32x4*)(p->out + (size_t)row * DM + cb + n * 16));
                else *(f32x4*)xp = r;
            }
    }
}

#define XB_TMO      128
#define XB_XCNT(j)  (256  + 64 * (j))
#define XB_XSUB(j)  (1280 + 64 * (j))
#define XB_XGEN(j)  (2304 + 64 * (j))
#define XB_TOP      3328
#define XB_TOPGEN   3392
#define XB_SPIN_CAP (1u << 18)
#define LAS __attribute__((address_space(3)))
DEVI unsigned xb_ld(unsigned* p) { return __hip_atomic_load(p, __ATOMIC_RELAXED, __HIP_MEMORY_SCOPE_AGENT); }
DEVI unsigned xb_add(unsigned* p, unsigned v) { return __hip_atomic_fetch_add(p, v, __ATOMIC_RELAXED, __HIP_MEMORY_SCOPE_AGENT); }
DEVI unsigned xb_xcc_id() { return (unsigned)__builtin_amdgcn_s_getreg((3 << 11) | 20) & 0xFu; }
#define XB_SPIN(cond, bar) do { unsigned _sp = 0; while (cond) { __builtin_amdgcn_s_sleep(1); \
    if ((++_sp & 255u) == 0u) { if (xb_ld(&(bar)[XB_TMO])) break; if (_sp > XB_SPIN_CAP) { atomicAdd(&(bar)[XB_TMO], 1u); break; } } } } while (0)
struct XcdBarrier { unsigned* bar; unsigned x; volatile LAS unsigned* st; };
DEVI XcdBarrier xcd_barrier_post(unsigned* bar, volatile LAS unsigned* st) {
    XcdBarrier b; b.bar = bar; b.x = xb_xcc_id(); b.st = st;
    if (__builtin_amdgcn_workitem_id_x() == 0) (void)xb_add(&bar[XB_XCNT(b.x)], 1u);
    return b;
}
DEVI void xcd_barrier_complete(unsigned* bar, unsigned x, unsigned& nloc, unsigned& nx) {
    const unsigned G = gridDim.x * gridDim.y * gridDim.z;
    unsigned sum, cnt, mine, sp = 0u;
    for (;;) {
        sum = 0u; cnt = 0u; mine = 0u;
#pragma unroll
        for (unsigned j = 0; j < 16; ++j) { const unsigned c = xb_ld(&bar[XB_XCNT(j)]); sum += c; cnt += (c > 0u) ? 1u : 0u; mine = (j == x) ? c : mine; }
        if (sum == G) break;
        __builtin_amdgcn_s_sleep(1);
        if ((++sp & 255u) == 0u) { if (xb_ld(&bar[XB_TMO])) break; if (sp > XB_SPIN_CAP) { atomicAdd(&bar[XB_TMO], 1u); break; } }
    }
    nloc = mine > 0u ? mine : 1u; nx = cnt > 0u ? cnt : 1u;
}
DEVI void xcd_barrier(const XcdBarrier& b) {
    asm volatile("s_waitcnt vmcnt(0)" ::: "memory");
    __syncthreads();
    if (__builtin_amdgcn_workitem_id_x() == 0) {
        unsigned* bar = b.bar;
        __builtin_amdgcn_s_waitcnt(0);
        unsigned nloc = b.st[0], nx = b.st[1];
        if (nloc == 0u) { xcd_barrier_complete(bar, b.x, nloc, nx); b.st[0] = nloc; b.st[1] = nx; }
        const unsigned old = xb_add(&bar[XB_XSUB(b.x)], 1u);
        const unsigned gen = old / nloc;
        if (old + 1u == (gen + 1u) * nloc) {
            __builtin_amdgcn_fence(__ATOMIC_RELEASE, "agent");
            asm volatile("s_waitcnt vmcnt(0)" ::: "memory");
            const unsigned og = xb_add(&bar[XB_TOP], 1u);
            const unsigned tg = og / nx;
            if (og + 1u == (tg + 1u) * nx) xb_add(&bar[XB_TOPGEN], 1u);
            else XB_SPIN(xb_ld(&bar[XB_TOPGEN]) == tg, bar);
            __builtin_amdgcn_fence(__ATOMIC_ACQUIRE, "agent");
            xb_add(&bar[XB_XGEN(b.x)], 1u);
            asm volatile("s_waitcnt vmcnt(0)" ::: "memory");
        } else {
            XB_SPIN(xb_ld(&bar[XB_XGEN(b.x)]) == gen, bar);
            __builtin_amdgcn_fence(__ATOMIC_ACQUIRE, "agent");
            asm volatile("s_waitcnt vmcnt(0)" ::: "memory");
        }
    }
    __syncthreads();
}

__global__ void __launch_bounds__(256, 2) mega(Params p_by_value) {
    cg::grid_group grid = cg::this_grid();
    __shared__ __attribute__((aligned(16))) unsigned char smem[SMEM_HALF];
    __shared__ __attribute__((aligned(16))) unsigned char smem1[SMEM_HALF];
    __shared__ uint4 xb_words;
    __shared__ int s_item[4];
    if (__builtin_amdgcn_workitem_id_x() == 0) xb_words = make_uint4(0u, 0u, 0u, 0u);
    __syncthreads();
    CP p = (CP)__builtin_amdgcn_kernarg_segment_ptr();
    if (launder(p)->out == nullptr) grid.sync();
    XcdBarrier xb = xcd_barrier_post(launder(p)->bar, (volatile LAS unsigned*)&xb_words);
    phase0(launder(p), smem);
    xcd_barrier(xb);
    for (int l = 0; l < 2; ++l) {
        if (l > 0) { CP q = launder(p); norm_phase(q->X, q->X + (size_t)NPR * DM, q->norm_mix + l * DM, q->H, nullptr); xcd_barrier(xb); }
        phase_gemm_in(launder(p), l, smem, smem1);
        xcd_barrier(xb);
        phase_mixers(launder(p), l, smem, smem1, s_item);
        xcd_barrier(xb);
        phase_merge<4>(launder(p), l, smem, smem1, 0, 128);
        phase_merge<1>(launder(p), l, smem, smem1, 128, 2);
        xcd_barrier(xb);
        { CP q = launder(p); phase_resid<4>(q, q->MG, DM, q->Wout + (size_t)l * DM * DM, l == 0, smem, smem1, 0, 128); }
        { CP q = launder(p); phase_resid<1>(q, q->MG, DM, q->Wout + (size_t)l * DM * DM, l == 0, smem, smem1, 128, 2); }
        xcd_barrier(xb);
        { CP q = launder(p); norm_phase(q->X, q->X + (size_t)NPR * DM, q->norm_ffn + l * DM, q->H, nullptr); }
        xcd_barrier(xb);
        phase_ffn_in(launder(p), l, smem, smem1);
        xcd_barrier(xb);
        { CP q = launder(p); phase_resid<4>(q, q->ACT, DFF, q->Wffo + (size_t)l * DM * DFF, false, smem, smem1, 0, 128); }
        { CP q = launder(p); phase_resid<1>(q, q->ACT, DFF, q->Wffo + (size_t)l * DM * DFF, false, smem, smem1, 128, 2); }
        xcd_barrier(xb);
        { CP q = launder(p); norm_phase(q->X, q->X + (size_t)NPR * DM, q->norm_ple + l * DM, q->H, nullptr); }
        xcd_barrier(xb);
        phase_ple<4>(launder(p), l, smem, smem1, 0, 128);
        phase_ple<1>(launder(p), l, smem, smem1, 128, 2);
        if (l == 0) xcd_barrier(xb);
    }
}

extern "C" void kernel_launch(void* const* d_in, const int* in_sizes, int n_in, void* d_out, int out_size, void* d_ws, size_t ws_size, hipStream_t stream) {
    static int grid_blocks = 0;
    if (!grid_blocks) {
        int dev = 0, cus = 0, per_cu = 0;
        hipGetDevice(&dev);
        hipDeviceGetAttribute(&cus, hipDeviceAttributeMultiprocessorCount, dev);
        hipOccupancyMaxActiveBlocksPerMultiprocessor(&per_cu, mega, 256, 0);
        if (per_cu > 2) per_cu = 2;
        if (per_cu < 1) per_cu = 1;
        grid_blocks = cus * per_cu;
    }
    Params hp{};
    const float** fin = (const float**)&hp;
    for (int i = 0; i < 27; ++i) fin[i] = (const float*)d_in[i];
    hp.out = (float*)d_out;
    unsigned char* ws = (unsigned char*)d_ws;
    size_t off = 0;
    auto take = [&](size_t bytes) { void* r = ws + off; off += (bytes + 255) & ~(size_t)255; return r; };
    hp.Win = (bf16_t*)take((size_t)2 * NIN * DM * 2);
    hp.Wa = (bf16_t*)take((size_t)2 * DM * 512 * 2);
    hp.Wb = (bf16_t*)take((size_t)2 * DM * 512 * 2);
    hp.Wc = (bf16_t*)take((size_t)2 * DM * 512 * 2);
    hp.Wout = (bf16_t*)take((size_t)2 * DM * DM * 2);
    hp.Wffi = (bf16_t*)take((size_t)2 * NFFI * DM * 2);
    hp.Wffo = (bf16_t*)take((size_t)2 * DM * DFF * 2);
    hp.Wpg = (bf16_t*)take((size_t)2 * DM * DM * 2);
    hp.Wpp = (bf16_t*)take((size_t)2 * DM * 256 * 2);
    hp.WS = (bf16_t*)take((size_t)2 * 4 * 128 * 128 * 2);
    hp.X = (float*)take((size_t)MT * DM * 4);
    hp.H = (bf16_t*)take((size_t)MT * DM * 2);
    hp.AU = (bf16_t*)take((size_t)MT * 512 * 2);
    hp.AVp = (bf16_t*)take((size_t)MT * 512 * 2);
    hp.BQ = (bf16_t*)take((size_t)MT * 512 * 2);
    hp.BK = (bf16_t*)take((size_t)MT * 128 * 2);
    hp.BV = (bf16_t*)take((size_t)MT * 128 * 2);
    hp.IQ = (bf16_t*)take((size_t)MT * 256 * 2);
    hp.IK = (bf16_t*)take((size_t)MT * 32 * 2);
    hp.IW = (float*)take((size_t)MT * 8 * 4);
    hp.CQ = (bf16_t*)take((size_t)MT * 512 * 2);
    hp.CK = (bf16_t*)take((size_t)MT * 512 * 2);
    hp.CV = (bf16_t*)take((size_t)MT * 512 * 2);
    hp.G = (bf16_t*)take((size_t)MT * 3072 * 2);
    hp.OA = (bf16_t*)take((size_t)MT * 512 * 2);
    hp.OB = (bf16_t*)take((size_t)MT * 512 * 2);
    hp.OC = (bf16_t*)take((size_t)MT * 512 * 2);
    hp.MG = (bf16_t*)take((size_t)MT * DM * 2);
    hp.ACT = (bf16_t*)take((size_t)MT * DFF * 2);
    hp.P = (bf16_t*)take((size_t)2 * MT * 256 * 2);
    hp.bar = (unsigned*)take((size_t)(XCD_BAR_WORDS + 256) * 4);
    hipMemsetAsync(hp.bar, 0, (size_t)(XCD_BAR_WORDS + 256) * 4, stream);
    void* args[] = {&hp};
    hipError_t e = hipLaunchCooperativeKernel((void*)mega, dim3(grid_blocks), dim3(256), args, 0, stream);
    if (e != hipSuccess) fprintf(stderr, "cooperative launch failed: %s (grid %d)\n", hipGetErrorString(e), grid_blocks);
}
```
